# Optimizing an MI355X kernel written in HIP

```python
import math
import jax, jax.numpy as jnp
from jax import lax
import numpy as np

D_MODEL = 1024
BATCH = 4
SEQ = 8192
DEPTH = 1

HGRN_HEADS = 8
HGRN_DK = 128
HGRN_DV = D_MODEL // HGRN_HEADS
HGRN_KEY_WIDTH = HGRN_HEADS * HGRN_DK
HGRN_WIDTH = HGRN_HEADS * HGRN_DV
HGRN_CHUNK = 64

HYENA_WIDTH = D_MODEL
HYENA_SHORT = 3
HYENA_BANDS = 16
HYENA_EMB = 1 + 2 * HYENA_BANDS
HYENA_FILTER_HIDDEN = 64
HYENA_MIN_DECAY = -math.log(1e-2) / 1.5
HYENA_MAX_DECAY = -math.log(1e-2) / 0.3

PEER_HEADS = 8
PEER_NKEYS = 128
PEER_EXPERTS = PEER_NKEYS * PEER_NKEYS
PEER_QDIM = 256
PEER_TOPK = 16
PEER_TOKEN_BLOCK = 128

N_BRANCHES = 2
IN_SPLITS = (HGRN_KEY_WIDTH, 2 * HGRN_KEY_WIDTH, 3 * HGRN_KEY_WIDTH,
             3 * HGRN_KEY_WIDTH + HGRN_WIDTH, 3 * HGRN_KEY_WIDTH + 2 * HGRN_WIDTH,
             3 * HGRN_KEY_WIDTH + 2 * HGRN_WIDTH + 3 * HYENA_WIDTH)
IN_COLS = 3 * HGRN_KEY_WIDTH + 2 * HGRN_WIDTH + 3 * HYENA_WIDTH + N_BRANCHES * D_MODEL
RMS_EPS = 1e-6

kernel_name = "hgrn2_hyena_peer_hybrid_block"


def rmsnorm(x, g):
    xf = x.astype(jnp.float32)
    y = xf * lax.rsqrt(jnp.mean(xf * xf, axis=-1, keepdims=True) + RMS_EPS)
    return (y * g.astype(jnp.float32)).astype(x.dtype)


def hgrn2_chunk_scan(q, k, logf, v):
    n, s, h, dk = q.shape
    dv = v.shape[-1]
    nc = s // HGRN_CHUNK

    def to_chunks(a):
        return a.reshape(n, nc, HGRN_CHUNK, h, a.shape[-1]).transpose(1, 0, 3, 2, 4)

    qc, kc, fc, vc = to_chunks(q), to_chunks(k), to_chunks(logf), to_chunks(v)
    incl = jnp.tril(jnp.ones((HGRN_CHUNK, HGRN_CHUNK), dtype=bool))[:, :, None]

    def step(state, inp):
        qb, kb, fb, vb = inp
        b = jnp.cumsum(fb, axis=2)
        b_last = b[:, :, -1:, :]
        inter = jnp.einsum('nhtk,nhkv->nhtv', qb * jnp.exp(b), state)
        diff = b[:, :, :, None, :] - b[:, :, None, :, :]
        decay = jnp.exp(jnp.where(incl, diff, -jnp.inf))
        scores = jnp.einsum('nhtk,nhsk,nhtsk->nhts', qb, kb, decay)
        intra = jnp.einsum('nhts,nhsv->nhtv', scores, vb)
        new_state = (jnp.exp(b_last[:, :, 0, :, None]) * state
                     + jnp.einsum('nhsk,nhsv->nhkv', kb * jnp.exp(b_last - b), vb))
        return new_state, inter + intra

    s0 = jnp.zeros((n, h, dk, dv), jnp.float32)
    _, out = lax.scan(step, s0, (qc, kc, fc, vc))
    return out.transpose(1, 0, 3, 2, 4).reshape(n, s, h, dv)


def centred_short_conv(x, w, b):
    L = x.shape[1]
    pad = HYENA_SHORT // 2
    xp = jnp.pad(x, ((0, 0), (pad, pad), (0, 0)))
    y = b
    for j in range(HYENA_SHORT):
        y = y + xp[:, j:j + L] * w[j]
    return y


def hyena_filters(seq_len, w1, b1, freq1, w2, b2, freq2, w3, decay_rate):
    f32 = jnp.float32
    pos = jnp.arange(seq_len, dtype=f32)
    t = pos / max(seq_len - 1, 1)
    bands = jnp.linspace(1e-4, HYENA_BANDS - 1, HYENA_BANDS, dtype=f32)
    ang = (2.0 * math.pi / seq_len) * pos[:, None] * bands[None, :]
    z = jnp.concatenate([t[:, None], jnp.cos(ang), -jnp.sin(ang)], axis=-1)
    hid = jnp.sin(freq1.astype(f32) * (z @ w1.astype(f32) + b1.astype(f32)))
    hid = jnp.sin(freq2.astype(f32) * (hid @ w2.astype(f32) + b2.astype(f32)))
    filt = (hid @ w3.astype(f32)) * jnp.exp(-t[:, None] * jnp.abs(decay_rate.astype(f32))[None, :])
    return filt[:, :HYENA_WIDTH], filt[:, HYENA_WIDTH:]


def bidirectional_fftconv(u, h_fwd, h_bwd, bias):
    L = u.shape[1]
    kern = jnp.concatenate([h_fwd, jnp.zeros_like(h_fwd[:1]), h_bwd[1:][::-1]], axis=0)
    uf32 = u.astype(jnp.float32)
    uf = jnp.fft.rfft(uf32, n=2 * L, axis=1)
    kf = jnp.fft.rfft(kern, n=2 * L, axis=0)
    y = jnp.fft.irfft(uf * kf[None], n=2 * L, axis=1)[:, :L]
    return (y + uf32 * bias.astype(jnp.float32)).astype(u.dtype)


def hybrid_mixer(xn, w_in, lb, hgrn_norm_g, conv_w, conv_b, filt_w1, filt_b1, filt_freq1,
                 filt_w2, filt_b2, filt_freq2, filt_w3, filt_decay, hyena_bias,
                 w_branch_a, w_branch_b, w_out):
    B, L, _ = xn.shape
    f32 = jnp.float32
    proj = jnp.einsum('bld,dc->blc', xn, w_in)
    q, zf_fwd, zf_bwd, inp, og, hy, gates = jnp.split(proj, IN_SPLITS, axis=-1)

    def heads(a, d):
        return a.astype(f32).reshape(B, L, HGRN_HEADS, d)

    lbh = lb.reshape(HGRN_HEADS, HGRN_DK)

    def forget(z):
        zh = heads(z, HGRN_DK)
        logf = jnp.log(lbh + (1.0 - lbh) * jax.nn.sigmoid(zh))
        k = (1.0 - lbh) * jax.nn.sigmoid(-zh)
        return logf, k

    logf_f, k_f = forget(zf_fwd)
    logf_b, k_b = forget(zf_bwd)
    qh = jax.nn.silu(heads(q, HGRN_DK))
    vh = heads(inp, HGRN_DV)
    rev = lambda a: a[:, ::-1]
    o2 = hgrn2_chunk_scan(jnp.concatenate([qh, rev(qh)], axis=0),
                          jnp.concatenate([k_f, rev(k_b)], axis=0),
                          jnp.concatenate([logf_f, rev(logf_b)], axis=0),
                          jnp.concatenate([vh, rev(vh)], axis=0))
    o = o2[:B] + rev(o2[B:])
    o = rmsnorm(o, hgrn_norm_g).reshape(B, L, HGRN_WIDTH)
    y_a = jnp.einsum('blc,cd->bld', (o * jax.nn.silu(og.astype(f32))).astype(xn.dtype), w_branch_a)

    hy = centred_short_conv(hy, conv_w, conv_b)
    x0, x1, v = jnp.split(hy, 3, axis=-1)
    h_f, h_b = hyena_filters(L, filt_w1, filt_b1, filt_freq1, filt_w2, filt_b2, filt_freq2,
                             filt_w3, filt_decay)
    y_b = x0 * bidirectional_fftconv(v * x1, h_f, h_b, hyena_bias)
    y_b = jnp.einsum('blc,cd->bld', y_b, w_branch_b)

    g_a, g_b = jnp.split(gates, N_BRANCHES, axis=-1)
    merged = jax.nn.sigmoid(g_a) * y_a + jax.nn.sigmoid(g_b) * y_b
    return jnp.einsum('bld,de->ble', merged, w_out)


def peer_ffn(xn, w_q, subkeys, u_tab, v_tab):
    B, L, D = xn.shape
    blocks = xn.reshape(-1, PEER_TOKEN_BLOCK, D)
    sk = subkeys.astype(jnp.float32)

    def block(xb):
        T = xb.shape[0]
        qh = (xb @ w_q).astype(jnp.float32).reshape(T, PEER_HEADS, 2, PEER_QDIM // 2)
        s = jnp.einsum('thpc,hpnc->thpn', qh, sk)
        s1, i1 = lax.top_k(s[:, :, 0], PEER_TOPK)
        s2, i2 = lax.top_k(s[:, :, 1], PEER_TOPK)
        cand_s = (s1[..., :, None] + s2[..., None, :]).reshape(T, PEER_HEADS, PEER_TOPK * PEER_TOPK)
        cand_i = (i1[..., :, None] * PEER_NKEYS + i2[..., None, :]).reshape(T, PEER_HEADS, PEER_TOPK * PEER_TOPK)
        top_s, pos = lax.top_k(cand_s, PEER_TOPK)
        experts = jnp.take_along_axis(cand_i, pos, axis=-1)
        g = jax.nn.softmax(top_s, axis=-1).astype(xb.dtype)
        u = jnp.take(u_tab, experts, axis=0)
        v = jnp.take(v_tab, experts, axis=0)
        act = jax.nn.gelu(jnp.einsum('td,thkd->thk', xb, u)) * g
        return jnp.einsum('thk,thkd->td', act, v)

    return lax.map(block, blocks).reshape(B, L, D)


def setup_inputs(seed: int = 0) -> dict:
    key = jax.random.key(seed)
    ks = jax.random.split(key, 26)

    def nrm(k, shape, scale):
        return jax.random.normal(k, shape, jnp.float32) * scale

    decay_base = jnp.linspace(HYENA_MIN_DECAY, HYENA_MAX_DECAY, 2 * HYENA_WIDTH, dtype=jnp.float32)
    return {
        "x": nrm(ks[0], (BATCH, SEQ, D_MODEL), 1.0),
        "norm_mix_g": 1.0 + nrm(ks[1], (DEPTH, D_MODEL), 0.02),
        "w_in": nrm(ks[2], (DEPTH, D_MODEL, IN_COLS), D_MODEL ** -0.5),
        "hgrn_lb_logits": nrm(ks[3], (DEPTH + 1, HGRN_KEY_WIDTH), 0.1),
        "hgrn_norm_g": 1.0 + nrm(ks[4], (DEPTH, HGRN_DV), 0.02),
        "hyena_conv_w": nrm(ks[5], (DEPTH, HYENA_SHORT, 3 * HYENA_WIDTH), HYENA_SHORT ** -0.5),
        "hyena_conv_b": nrm(ks[6], (DEPTH, 3 * HYENA_WIDTH), 0.02),
        "filt_w1": nrm(ks[7], (DEPTH, HYENA_EMB, HYENA_FILTER_HIDDEN), HYENA_EMB ** -0.5),
        "filt_b1": nrm(ks[8], (DEPTH, HYENA_FILTER_HIDDEN), 0.1),
        "filt_freq1": 1.0 + nrm(ks[9], (DEPTH, HYENA_FILTER_HIDDEN), 0.02),
        "filt_w2": nrm(ks[10], (DEPTH, HYENA_FILTER_HIDDEN, HYENA_FILTER_HIDDEN), HYENA_FILTER_HIDDEN ** -0.5),
        "filt_b2": nrm(ks[11], (DEPTH, HYENA_FILTER_HIDDEN), 0.1),
        "filt_freq2": 1.0 + nrm(ks[12], (DEPTH, HYENA_FILTER_HIDDEN), 0.02),
        "filt_w3": nrm(ks[13], (DEPTH, HYENA_FILTER_HIDDEN, 2 * HYENA_WIDTH), 0.02 * HYENA_FILTER_HIDDEN ** -0.5),
        "filt_decay": decay_base[None, :] + nrm(ks[14], (DEPTH, 2 * HYENA_WIDTH), 0.1),
        "hyena_bias": nrm(ks[15], (DEPTH, HYENA_WIDTH), 0.1),
        "w_branch_a": nrm(ks[16], (DEPTH, HGRN_WIDTH, D_MODEL), HGRN_WIDTH ** -0.5),
        "w_branch_b": nrm(ks[17], (DEPTH, HYENA_WIDTH, D_MODEL), HYENA_WIDTH ** -0.5),
        "w_out": nrm(ks[18], (DEPTH, D_MODEL, D_MODEL), D_MODEL ** -0.5),
        "norm_ffn_g": 1.0 + nrm(ks[19], (DEPTH, D_MODEL), 0.02),
        "peer_w_q": nrm(ks[20], (DEPTH, D_MODEL, PEER_HEADS * PEER_QDIM), D_MODEL ** -0.5),
        "peer_subkeys": nrm(ks[21], (DEPTH, PEER_HEADS, 2, PEER_NKEYS, PEER_QDIM // 2), (PEER_QDIM // 2) ** -0.5),
        "peer_u": nrm(ks[22], (DEPTH, PEER_EXPERTS, D_MODEL), D_MODEL ** -0.5),
        "peer_v": nrm(ks[23], (DEPTH, PEER_EXPERTS, D_MODEL), 0.2),
        "norm_final_g": 1.0 + nrm(ks[24], (D_MODEL,), 0.02),
    }


def reference(x, norm_mix_g, w_in, hgrn_lb_logits, hgrn_norm_g, hyena_conv_w, hyena_conv_b,
              filt_w1, filt_b1, filt_freq1, filt_w2, filt_b2, filt_freq2, filt_w3, filt_decay,
              hyena_bias, w_branch_a, w_branch_b, w_out, norm_ffn_g, peer_w_q, peer_subkeys,
              peer_u, peer_v, norm_final_g):
    lb_table = jnp.cumsum(jax.nn.softmax(hgrn_lb_logits.astype(jnp.float32), axis=0), axis=0)
    h = x
    for layer in range(DEPTH):
        h = h + hybrid_mixer(rmsnorm(h, norm_mix_g[layer]), w_in[layer], lb_table[layer],
                             hgrn_norm_g[layer], hyena_conv_w[layer], hyena_conv_b[layer],
                             filt_w1[layer], filt_b1[layer], filt_freq1[layer],
                             filt_w2[layer], filt_b2[layer], filt_freq2[layer],
                             filt_w3[layer], filt_decay[layer], hyena_bias[layer],
                             w_branch_a[layer], w_branch_b[layer], w_out[layer])
        h = h + peer_ffn(rmsnorm(h, norm_ffn_g[layer]), peer_w_q[layer], peer_subkeys[layer],
                         peer_u[layer], peer_v[layer])
    return rmsnorm(h, norm_final_g)
```

```cpp
#include <hip/hip_runtime.h>
#include <hip/hip_cooperative_groups.h>
#include <cstdio>
#include <cstdint>
namespace cg = cooperative_groups;
namespace pg8 {
#define PG8_LAS __attribute__((address_space(3)))
typedef unsigned short bf16_t;
typedef short bf16x8 __attribute__((ext_vector_type(8)));
typedef float f32x4 __attribute__((ext_vector_type(4)));
typedef unsigned u32x4 __attribute__((ext_vector_type(4)));
constexpr int BM = 256, BK = 64, HALF = 128, HTB = HALF * BK * 2  , STAGE_BYTES = 8 * HTB, NXCD = 8, WGM = 8;

__host__ __device__ __forceinline__ int lds_byte(int r, int c) { const int st = (r >> 4) * 2 + (c >> 5), rr = r & 15, cc = c & 31, ob = rr * 64 + cc * 2; return st * 1024 + (ob ^ (((ob >> 9) & 1) << 5)); }
__host__ __device__ __forceinline__ void stage_rc(int b, int& R, int& C) { const int st = b / 1024, sb = b % 1024, swz = sb ^ (((sb >> 9) & 1) << 5); R = (st >> 1) * 16 + swz / 64; C = (st & 1) * 32 + (swz % 64) / 2; }
__host__ __device__ __forceinline__ int perm32(int rho) { const int n = rho >> 4, i = rho & 15; return 8 * (i >> 2) + 4 * n + (i & 3); }

struct Unit { int pm, pn; };
struct Gemm { const bf16_t* A; const bf16_t* Bt; int M, N, K; };

struct StaticOrder {
    int nM, nN, nwg, G, c;
    __host__ __device__ void init(int M, int N, int G_, int c_) { nM = M / BM; nN = N / BM; nwg = nM * nN; G = G_; c = c_; }
    __host__ __device__ bool next(int i, Unit& u) const {
        const long L = (long)i * G + c; if (L >= nwg) return false;
        int wgid = (int)L; { const int q = nwg / NXCD, r = nwg % NXCD, xcd = wgid % NXCD, off = wgid / NXCD; wgid = (xcd < r ? xcd * (q + 1) : r * (q + 1) + (xcd - r) * q) + off; }
        const int nig = WGM * nN, gid = wgid / nig, fm = gid * WGM, gsz = (nM - fm) < WGM ? (nM - fm) : WGM;
        u.pm = fm + ((wgid % nig) % gsz); u.pn = (wgid % nig) / gsz; return true;
    }
    __device__ __forceinline__ void a_ready(const Unit&) const {}
    __device__ __forceinline__ void done(const Unit&) const {}
};

typedef float cvt_f32x2_t __attribute__((ext_vector_type(2))); typedef __bf16 cvt_bf16x2_t __attribute__((ext_vector_type(2)));
__device__ __forceinline__ unsigned cvt_pk_bf16(float lo, float hi) { cvt_f32x2_t v = {lo, hi}; cvt_bf16x2_t b = __builtin_convertvector(v, cvt_bf16x2_t); return __builtin_bit_cast(unsigned, b); }
__device__ __forceinline__ float bfl(unsigned w) { return __uint_as_float(w << 16); }
__device__ __forceinline__ float bfh(unsigned w) { return __uint_as_float(w & 0xffff0000u); }
__device__ __forceinline__ float sigmoidf_(float x) { return __builtin_amdgcn_rcpf(1.0f + __expf(-x)); }
struct EpiGen {
    static constexpr bool PERM = true, AFTER_DRAIN = false;
    bf16_t *o0, *o1, *o2, *o3, *o4;
    int actbits;
    int mulmask;
    const bf16_t* mul; const bf16_t* add;
    const float* resid; float* outf;
    __device__ __forceinline__ void operator()(const f32x4 (&acc)[2][2][4][2], const Unit& u, int wr, int wc, int fr, int fq) const {
        const int grp = u.pn >> 2;
        bf16_t* base = grp == 0 ? o0 : grp == 1 ? o1 : grp == 2 ? o2 : grp == 3 ? o3 : o4;
        const int act = (actbits >> (2 * grp)) & 3;
        const int row0 = u.pm * BM + wr * 64 + fr, col0 = (u.pn & 3) * BM + wc * 32 + 8 * fq;
#pragma unroll
        for (int ai = 0; ai < 2; ++ai)
#pragma unroll
            for (int m = 0; m < 4; ++m) {
                const size_t off = (size_t)(row0 + ai * HALF + m * 16) * 1024 + col0;
#pragma unroll
                for (int bj = 0; bj < 2; ++bj) {
                    f32x4 v0 = acc[ai][bj][m][0], v1 = acc[ai][bj][m][1];
                    const size_t o = off + bj * HALF;
                    if (act == 1) {
#pragma unroll
                        for (int e = 0; e < 4; ++e) { v0[e] = v0[e] * sigmoidf_(v0[e]); v1[e] = v1[e] * sigmoidf_(v1[e]); }
                    } else if (act == 2) {
#pragma unroll
                        for (int e = 0; e < 4; ++e) { v0[e] = sigmoidf_(v0[e]); v1[e] = sigmoidf_(v1[e]); }
                    }
                    if (mul && ((mulmask >> grp) & 1)) { const u32x4 mv = *(const u32x4*)(mul + o);
                        v0[0] *= bfl(mv.x); v0[1] *= bfh(mv.x); v0[2] *= bfl(mv.y); v0[3] *= bfh(mv.y); v1[0] *= bfl(mv.z); v1[1] *= bfh(mv.z); v1[2] *= bfl(mv.w); v1[3] *= bfh(mv.w); }
                    if (add) { const u32x4 av = *(const u32x4*)(add + o);
                        v0[0] += bfl(av.x); v0[1] += bfh(av.x); v0[2] += bfl(av.y); v0[3] += bfh(av.y); v1[0] += bfl(av.z); v1[1] += bfh(av.z); v1[2] += bfl(av.w); v1[3] += bfh(av.w); }
                    if (resid && !outf) { const f32x4 r0 = *(const f32x4*)(resid + o), r1 = *(const f32x4*)(resid + o + 4); v0 = v0 + r0; v1 = v1 + r1; }
                    if (outf) {
                        const f32x4 r0 = *(const f32x4*)(resid + o), r1 = *(const f32x4*)(resid + o + 4);
                        *(f32x4*)(outf + o) = v0 + r0; *(f32x4*)(outf + o + 4) = v1 + r1;
                    } else {
                        u32x4 w; w.x = cvt_pk_bf16(v0[0], v0[1]); w.y = cvt_pk_bf16(v0[2], v0[3]); w.z = cvt_pk_bf16(v1[0], v1[1]); w.w = cvt_pk_bf16(v1[2], v1[3]);
                        *(u32x4*)(base + o) = w;
                    }
                }
            }
    }
};
template <class Epi, class Sched, bool ALIGN_EPI = false, bool SP2 = false>
__device__ __forceinline__ void gemm_phase(PG8_LAS unsigned char* lds, const Gemm g, const Sched& S, const Epi& E) {
    const int tid = threadIdx.x, wid = __builtin_amdgcn_readfirstlane(tid >> 6), lane = tid & 63, wr = wid >> 2, wc = wid & 3, fr = lane & 15, fq = lane >> 4;
    const int K = g.K, nt = K / BK;
    unsigned voffA[2], voffB[2];
#pragma unroll
    for (int i = 0; i < 2; ++i) { int R, C; stage_rc(tid * 16 + i * 8192, R, C); const int Rb = Epi::PERM ? ((R & ~31) + perm32(R & 31)) : R;
        voffA[i] = (unsigned)(R * K + C) * 2u; voffB[i] = (unsigned)(Rb * K + C) * 2u; }
    const size_t kstep = (size_t)(BK * 2);
    const size_t hstep = (size_t)HALF * K * 2;
    const size_t tstep = 2 * hstep;
    const unsigned ldsw = (unsigned)wid * 1024u;
    const int aoff = lds_byte(wr * 64 + fr, fq * 8), boff = lds_byte(wc * 32 + fr, fq * 8);
#define PG8_SA(b, h) (((b) * 2 + (h)) * HTB)
#define PG8_SB(b, h) ((4 + (b) * 2 + (h)) * HTB)
#define PG8_STAGE(bufoff, gbase, voff) do { _Pragma("unroll") for (int _i = 0; _i < 2; ++_i) \
        __builtin_amdgcn_global_load_lds((const unsigned*)((const char*)(gbase) + (voff)[_i]), (PG8_LAS unsigned*)(lds + (bufoff) + ldsw + _i * 8192), 16, 0, 0); } while (0)
#define PG8_LDA(dst, b, h) do { _Pragma("unroll") for (int m = 0; m < 4; ++m) _Pragma("unroll") for (int k = 0; k < 2; ++k) dst[m][k] = *(const PG8_LAS bf16x8*)(lds + PG8_SA(b, h) + aoff + m * 2048 + k * 1024); } while (0)
#define PG8_LDB(dst, b, h) do { _Pragma("unroll") for (int n = 0; n < 2; ++n) _Pragma("unroll") for (int k = 0; k < 2; ++k) dst[n][k] = *(const PG8_LAS bf16x8*)(lds + PG8_SB(b, h) + boff + n * 2048 + k * 1024); } while (0)
#define PG8_MMA(ai, bj, At, Bt) do { __builtin_amdgcn_s_setprio(1); _Pragma("unroll") for (int m = 0; m < 4; ++m) _Pragma("unroll") for (int n = 0; n < 2; ++n) _Pragma("unroll") for (int k = 0; k < 2; ++k) \
        acc[ai][bj][m][n] = __builtin_amdgcn_mfma_f32_16x16x32_bf16(Bt[n][k], At[m][k], acc[ai][bj][m][n], 0, 0, 0); __builtin_amdgcn_s_setprio(0); } while (0)
#define PG8_WAIT_V(n) asm volatile("s_waitcnt vmcnt(" #n ")" ::: "memory")
#define PG8_WAIT_L(n) asm volatile("s_waitcnt lgkmcnt(" #n ")" ::: "memory")
#define PG8_BAR __builtin_amdgcn_s_barrier()
#define PG8_SCHED __builtin_amdgcn_sched_barrier(0)
    Unit cur, nxt; int ui = 0;
    if (!S.next(0, cur)) return;
    f32x4 acc[2][2][4][2];
#pragma unroll
    for (int a = 0; a < 2; ++a)
#pragma unroll
        for (int b = 0; b < 2; ++b)
#pragma unroll
            for (int m = 0; m < 4; ++m)
#pragma unroll
                for (int n = 0; n < 2; ++n) acc[a][b][m][n] = (f32x4){0.f, 0.f, 0.f, 0.f};
    bf16x8 At[4][2], B0[2][2], B1[2][2];
    const char* cA = (const char*)g.A + (size_t)cur.pm * tstep; const char* cB = (const char*)g.Bt + (size_t)cur.pn * tstep;
    S.a_ready(cur);
    if constexpr (SP2) {
        PG8_STAGE(PG8_SB(0, 0), cB, voffB); PG8_STAGE(PG8_SB(0, 1), cB + hstep, voffB); PG8_STAGE(PG8_SA(0, 0), cA, voffA); PG8_STAGE(PG8_SA(0, 1), cA + hstep, voffA);
        if (wr == 1) PG8_BAR;
        PG8_WAIT_V(2); PG8_BAR;
        PG8_STAGE(PG8_SB(1, 0), cB + kstep, voffB); PG8_STAGE(PG8_SA(1, 0), cA + kstep, voffA); PG8_STAGE(PG8_SB(1, 1), cB + hstep + kstep, voffB);
        PG8_WAIT_V(6); PG8_BAR;
    } else {
        PG8_STAGE(PG8_SB(0, 0), cB, voffB); PG8_STAGE(PG8_SA(0, 0), cA, voffA); PG8_STAGE(PG8_SB(0, 1), cB + hstep, voffB); PG8_STAGE(PG8_SA(0, 1), cA + hstep, voffA);
        if (wr == 1) PG8_BAR;
        PG8_WAIT_V(4); PG8_BAR;
        PG8_STAGE(PG8_SB(1, 0), cB + kstep, voffB); PG8_STAGE(PG8_SA(1, 0), cA + kstep, voffA); PG8_STAGE(PG8_SB(1, 1), cB + hstep + kstep, voffB);
        PG8_WAIT_V(6); PG8_BAR;
    }
    for (;;) {
        const bool has_next = S.next(ui + 1, nxt);
        const char* nA = has_next ? (const char*)g.A + (size_t)nxt.pm * tstep : cA; const char* nB = has_next ? (const char*)g.Bt + (size_t)nxt.pn * tstep : cB;
        for (int t = 0; t < nt; t += 2) {
            const bool last = (t == nt - 2);
            const char* a1 = cA + (size_t)(t + 1) * kstep;
            const char* a2 = last ? nA : cA + (size_t)(t + 2) * kstep; const char* b2 = last ? nB : cB + (size_t)(t + 2) * kstep;
            const char* a3 = a2 + kstep; const char* b3 = b2 + kstep;
            if (last && has_next) S.a_ready(nxt);
            if constexpr (SP2) {
            PG8_LDB(B0, 0, 0); PG8_LDB(B1, 0, 1); PG8_SCHED; PG8_LDA(At, 0, 0); PG8_STAGE(PG8_SA(1, 1), a1 + hstep, voffA);
            PG8_WAIT_V(8); PG8_WAIT_L(0); PG8_BAR; PG8_MMA(0, 0, At, B0); PG8_MMA(0, 1, At, B1); PG8_BAR; PG8_SCHED;
            PG8_LDA(At, 0, 1); PG8_STAGE(PG8_SB(0, 0), b2, voffB); PG8_STAGE(PG8_SB(0, 1), b2 + hstep, voffB); PG8_STAGE(PG8_SA(0, 0), a2, voffA);
            PG8_WAIT_V(8); PG8_WAIT_L(0); PG8_BAR; PG8_MMA(1, 0, At, B0); PG8_MMA(1, 1, At, B1); PG8_BAR; PG8_SCHED;
            PG8_LDB(B0, 1, 0); PG8_LDB(B1, 1, 1); PG8_SCHED; PG8_LDA(At, 1, 0); PG8_STAGE(PG8_SA(0, 1), a2 + hstep, voffA);
            PG8_WAIT_V(8); PG8_WAIT_L(0); PG8_BAR; PG8_MMA(0, 0, At, B0); PG8_MMA(0, 1, At, B1); PG8_BAR; PG8_SCHED;
            PG8_LDA(At, 1, 1); PG8_STAGE(PG8_SB(1, 0), b3, voffB); PG8_STAGE(PG8_SB(1, 1), b3 + hstep, voffB); PG8_STAGE(PG8_SA(1, 0), a3, voffA);
            PG8_WAIT_V(8); PG8_WAIT_L(0); PG8_BAR; PG8_MMA(1, 0, At, B0); PG8_MMA(1, 1, At, B1); PG8_BAR; PG8_SCHED;
            } else {
            PG8_LDB(B0, 0, 0); PG8_SCHED; PG8_LDA(At, 0, 0); PG8_STAGE(PG8_SA(1, 1), a1 + hstep, voffA);
            PG8_WAIT_L(8); PG8_BAR; PG8_WAIT_L(0); PG8_MMA(0, 0, At, B0); PG8_BAR; PG8_SCHED;
            PG8_LDB(B1, 0, 1); PG8_STAGE(PG8_SB(0, 0), b2, voffB);
            PG8_BAR; PG8_WAIT_L(0); PG8_MMA(0, 1, At, B1); PG8_BAR;
            PG8_LDA(At, 0, 1); PG8_STAGE(PG8_SA(0, 0), a2, voffA);
            PG8_BAR; PG8_WAIT_L(0); PG8_MMA(1, 0, At, B0); PG8_BAR; PG8_SCHED;
            PG8_STAGE(PG8_SB(0, 1), b2 + hstep, voffB);
            PG8_WAIT_V(6); PG8_BAR; PG8_MMA(1, 1, At, B1); PG8_BAR;
            PG8_LDB(B0, 1, 0); PG8_SCHED; PG8_LDA(At, 1, 0); PG8_STAGE(PG8_SA(0, 1), a2 + hstep, voffA);
            PG8_WAIT_L(8); PG8_BAR; PG8_WAIT_L(0); PG8_MMA(0, 0, At, B0); PG8_BAR; PG8_SCHED;
            PG8_LDB(B1, 1, 1); PG8_STAGE(PG8_SB(1, 0), b3, voffB);
            PG8_BAR; PG8_WAIT_L(0); PG8_MMA(0, 1, At, B1); PG8_BAR;
            PG8_LDA(At, 1, 1); PG8_STAGE(PG8_SA(1, 0), a3, voffA);
            PG8_BAR; PG8_WAIT_L(0); PG8_MMA(1, 0, At, B0); PG8_BAR; PG8_SCHED;
            PG8_STAGE(PG8_SB(1, 1), b3 + hstep, voffB);
            PG8_WAIT_V(6); PG8_BAR; PG8_MMA(1, 1, At, B1); PG8_BAR;
            }
        }
        if constexpr (ALIGN_EPI) { if (wr == 0) PG8_BAR; }
        if constexpr (!Epi::AFTER_DRAIN) { E(acc, cur, wr, wc, fr, fq); S.done(cur); }
        if (!has_next) break;
#pragma unroll
        for (int a = 0; a < 2; ++a)
#pragma unroll
            for (int b = 0; b < 2; ++b)
#pragma unroll
                for (int m = 0; m < 4; ++m)
#pragma unroll
                    for (int n = 0; n < 2; ++n) acc[a][b][m][n] = (f32x4){0.f, 0.f, 0.f, 0.f};
        cur = nxt; cA = nA; cB = nB; ++ui;
        if constexpr (ALIGN_EPI) { if (wr == 1) PG8_BAR; }
    }
    PG8_WAIT_V(0);
    if constexpr (!ALIGN_EPI) { if (wr == 0) PG8_BAR; }
    PG8_BAR;
    if constexpr (Epi::AFTER_DRAIN) { E.fused(acc, cur, wr, wc, fr, fq, lds, wid, lane); S.done(cur); }
#undef PG8_SA
#undef PG8_SB
#undef PG8_STAGE
#undef PG8_LDA
#undef PG8_LDB
#undef PG8_MMA
#undef PG8_WAIT_V
#undef PG8_WAIT_L
#undef PG8_BAR
#undef PG8_SCHED
}
}
constexpr int T_ = 32768, D_ = 1024, L_ = 8192, NB_ = 4;
constexpr size_t MiB = 1u << 20;
constexpr size_t WS_WIN = 1 * MiB;
constexpr size_t WS_WA = 21 * MiB, WS_WB = 23 * MiB, WS_WO = 25 * MiB;
constexpr size_t WS_WQ = 27 * MiB;
constexpr size_t WS_SK = 31 * MiB;
constexpr size_t WS_HID = 32 * MiB;
constexpr size_t WS_FAC = 34 * MiB;
constexpr size_t WS_XN = 64 * MiB;
constexpr size_t WS_R0 = 128 * MiB, WS_RS = 64 * MiB;
constexpr size_t WS_END = 512 * MiB;
constexpr int LDS_BYTES = 147456;
constexpr int NTHREADS = 512;
#ifndef GSYNC_EVERY
#define GSYNC_EVERY 0
#endif

#define LAS __attribute__((address_space(3)))
typedef unsigned short bf16_t;
typedef float f32x4 __attribute__((ext_vector_type(4)));
typedef float f32x16 __attribute__((ext_vector_type(16)));
typedef unsigned u32x4 __attribute__((ext_vector_type(4)));
typedef unsigned u32x2 __attribute__((ext_vector_type(2)));
typedef short bf16x8 __attribute__((ext_vector_type(8)));
typedef short v4i16_t __attribute__((ext_vector_type(4)));

__device__ __forceinline__ float bf2f(bf16_t v) { return __uint_as_float((unsigned)v << 16); }
__device__ __forceinline__ float bflo(unsigned w) { return __uint_as_float(w << 16); }
__device__ __forceinline__ float bfhi(unsigned w) { return __uint_as_float(w & 0xffff0000u); }
__device__ __forceinline__ unsigned pk2(float lo, float hi) { return pg8::cvt_pk_bf16(lo, hi); }
__device__ __forceinline__ bf16_t f2bf(float f) { return (bf16_t)(pk2(f, 0.f) & 0xffffu); }
__device__ __forceinline__ float wave_sum(float v) {
#pragma unroll
    for (int o = 1; o < 64; o <<= 1) v += __shfl_xor(v, o);
    return v;
}
#define LDS_WAIT() asm volatile("s_waitcnt lgkmcnt(0)" ::: "memory")

struct Params { const float* in[25]; float* out; unsigned char* ws; int ph_lo, ph_hi, bar_region, pad; };

typedef float cf2 __attribute__((ext_vector_type(2)));
#define FFT_HD __device__ __forceinline__
#define FFT_LDS LAS
#define FFT_COSREV(x) __builtin_amdgcn_cosf(x)
#define FFT_SINREV(x) __builtin_amdgcn_sinf(x)
#ifndef FFT_HD
#define FFT_HD __device__ __forceinline__
#endif
FFT_HD float c32f(int m) {
    const float t[32] = {1.000000000e+00f, 9.807852804e-01f, 9.238795325e-01f, 8.314696123e-01f, 7.071067812e-01f, 5.555702330e-01f, 3.826834324e-01f, 1.950903220e-01f, 0.f, -1.950903220e-01f, -3.826834324e-01f, -5.555702330e-01f, -7.071067812e-01f, -8.314696123e-01f, -9.238795325e-01f, -9.807852804e-01f, -1.000000000e+00f, -9.807852804e-01f, -9.238795325e-01f, -8.314696123e-01f, -7.071067812e-01f, -5.555702330e-01f, -3.826834324e-01f, -1.950903220e-01f, 0.f, 1.950903220e-01f, 3.826834324e-01f, 5.555702330e-01f, 7.071067812e-01f, 8.314696123e-01f, 9.238795325e-01f, 9.807852804e-01f};
    return t[m & 31];
}
FFT_HD float s32f(int m) { return c32f(m + 24); }

template <int NP, int SIGN>
FFT_HD void dft_pow2(float (&re)[NP], float (&im)[NP]) {
    constexpr int LOG = (NP == 32) ? 5 : 4;
#pragma unroll
    for (int st = 0; st < LOG; ++st) {
        const int half = NP >> (st + 1);
#pragma unroll
        for (int b = 0; b < NP; b += 2 * half) {
#pragma unroll
            for (int i = 0; i < half; ++i) {
                const int p = b + i, q = b + i + half;
                const float ur = re[p], ui = im[p], vr = re[q], vi = im[q];
                re[p] = ur + vr; im[p] = ui + vi;
                const float dr = ur - vr, di = ui - vi;
                const int m = i * (16 / half);
                const float c = c32f(m), s = (float)SIGN * s32f(m);
                if (m == 0) { re[q] = dr; im[q] = di; }
                else if (m == 8) { re[q] = -s * di; im[q] = s * dr; }
                else { re[q] = dr * c - di * s; im[q] = dr * s + di * c; }
            }
        }
    }
    float tr[NP], ti[NP];
#pragma unroll
    for (int i = 0; i < NP; ++i) {
        int r = 0;
#pragma unroll
        for (int bb = 0; bb < LOG; ++bb) r |= ((i >> bb) & 1) << (LOG - 1 - bb);
        tr[r] = re[i]; ti[r] = im[i];
    }
#pragma unroll
    for (int i = 0; i < NP; ++i) { re[i] = tr[i]; im[i] = ti[i]; }
}

template <int SIGN>
FFT_HD void twid(int m, float& c, float& s) {
    const float x = (float)m * (1.0f / 16384.0f);
    c = FFT_COSREV(x); s = (float)SIGN * FFT_SINREV(x);
}
FFT_HD int fftA(int i) { return i + (i >> 5); }

FFT_HD void fft_fwd_p1(float (&re)[16], float (&im)[16], int r_, FFT_LDS cf2* lds, int salt) {
    const int r = r_ + salt;
    dft_pow2<16, -1>(re, im);
    float wc, ws; twid<-1>(r, wc, ws);
    float c = 1.0f, s = 0.0f;
#pragma unroll
    for (int k1 = 0; k1 < 16; ++k1) {
        const float a = re[k1], b = im[k1];
        cf2 o; o.x = a * c - b * s; o.y = a * s + b * c;
        lds[fftA(k1 * 1024 + r)] = o;
        const float cn = c * wc - s * ws, sn = c * ws + s * wc; c = cn; s = sn;
    }
}
FFT_HD void fft_fwd_p2(int tid_, FFT_LDS cf2* lds, int salt) {
    const int tid = tid_ + salt, k1 = tid >> 5, r2 = tid & 31;
    float re[32], im[32];
#pragma unroll
    for (int j = 0; j < 32; ++j) { const cf2 v = lds[fftA(k1 * 1024 + j * 32 + r2)]; re[j] = v.x; im[j] = v.y; }
    dft_pow2<32, -1>(re, im);
    float wc, ws; twid<-1>(16 * r2, wc, ws);
    float c = 1.0f, s = 0.0f;
#pragma unroll
    for (int k2 = 0; k2 < 32; ++k2) {
        const float a = re[k2], b = im[k2];
        cf2 o; o.x = a * c - b * s; o.y = a * s + b * c;
        lds[fftA(k1 * 1024 + k2 * 32 + r2)] = o;
        const float cn = c * wc - s * ws, sn = c * ws + s * wc; c = cn; s = sn;
    }
}
FFT_HD void fft_fwd_p3(int tid, FFT_LDS cf2* lds, float (&re)[32], float (&im)[32]) {
    const int base = fftA((tid >> 5) * 1024 + (tid & 31) * 32);
#pragma unroll
    for (int j = 0; j < 32; ++j) { const cf2 v = lds[base + j]; re[j] = v.x; im[j] = v.y; }
    dft_pow2<32, -1>(re, im);
}
FFT_HD void fft_inv_p3(int tid_, FFT_LDS cf2* lds, float (&re)[32], float (&im)[32], int salt) {
    const int tid = tid_ + salt, k2 = tid & 31, base = fftA((tid >> 5) * 1024 + k2 * 32);
    dft_pow2<32, +1>(re, im);
    float wc, ws; twid<+1>(16 * k2, wc, ws);
    float c = 1.0f, s = 0.0f;
#pragma unroll
    for (int r2 = 0; r2 < 32; ++r2) {
        const float a = re[r2], b = im[r2];
        cf2 o; o.x = a * c - b * s; o.y = a * s + b * c;
        lds[base + r2] = o;
        const float cn = c * wc - s * ws, sn = c * ws + s * wc; c = cn; s = sn;
    }
}
FFT_HD void fft_inv_p2(int tid_, FFT_LDS cf2* lds, int salt) {
    const int tid = tid_ + salt, k1 = tid >> 5, r2 = tid & 31;
    float re[32], im[32];
#pragma unroll
    for (int j = 0; j < 32; ++j) { const cf2 v = lds[fftA(k1 * 1024 + j * 32 + r2)]; re[j] = v.x; im[j] = v.y; }
    dft_pow2<32, +1>(re, im);
    float wc, ws; twid<+1>(32 * k1, wc, ws);
    float c, s; twid<+1>(r2 * k1, c, s);
#pragma unroll
    for (int j2 = 0; j2 < 32; ++j2) {
        const float a = re[j2], b = im[j2];
        cf2 o; o.x = a * c - b * s; o.y = a * s + b * c;
        lds[fftA(k1 * 1024 + j2 * 32 + r2)] = o;
        const float cn = c * wc - s * ws, sn = c * ws + s * wc; c = cn; s = sn;
    }
}
FFT_HD void fft_inv_p1(float (&re)[16], float (&im)[16], int r, FFT_LDS cf2* lds) {
#pragma unroll
    for (int k1 = 0; k1 < 16; ++k1) { const cf2 v = lds[fftA(k1 * 1024 + r)]; re[k1] = v.x; im[k1] = v.y; }
    dft_pow2<16, +1>(re, im);
}


__device__ __forceinline__ void transpose_item(const float* W, int K, int N, bf16_t* WT, LAS float* scr, int item, int lane, bool perm_in = false) {
    const int nblk = N / 32, kb = item / nblk, nb = item % nblk, k0 = 64 * kb, n0 = 32 * nb;
    const int rshift = perm_in ? ((n0 >= 4096 && n0 < 5120) ? 3072 : (n0 >= 5120 && n0 < 8192) ? -1024 : 0) : 0;
#pragma unroll 8
    for (int i = 0; i < 32; ++i) { const int kk = 2 * i + (lane >> 5); scr[kk * 33 + (lane & 31)] = W[(size_t)(k0 + kk) * N + n0 + (lane & 31)]; }
    LDS_WAIT();
    const int c = lane & 7;
#pragma unroll
    for (int j = 0; j < 4; ++j) { const int n = (lane >> 3) + 8 * j; const LAS float* s = scr + (8 * c) * 33 + n;
        u32x4 o; o.x = pk2(s[0 * 33], s[1 * 33]); o.y = pk2(s[2 * 33], s[3 * 33]); o.z = pk2(s[4 * 33], s[5 * 33]); o.w = pk2(s[6 * 33], s[7 * 33]);
        *(u32x4*)(WT + (size_t)(n0 + n + rshift) * K + k0 + 8 * c) = o; }
    LDS_WAIT();
}
__device__ __forceinline__ void rms_row_to_bf16(const float* xrow, const float* g, bf16_t* orow, int lane) {
    const f32x4* xr = (const f32x4*)xrow + lane; f32x4 v[4]; float s = 0.f;
#pragma unroll
    for (int j = 0; j < 4; ++j) { v[j] = xr[64 * j]; s += (v[j].x * v[j].x + v[j].y * v[j].y) + (v[j].z * v[j].z + v[j].w * v[j].w); }
    const float rs = rsqrtf(wave_sum(s) * (1.0f / 1024.0f) + 1e-6f);
    u32x2* o8 = (u32x2*)orow + lane;
#pragma unroll
    for (int j = 0; j < 4; ++j) { const f32x4 gv = ((const f32x4*)g)[lane + 64 * j]; u32x2 w; w.x = pk2(v[j].x * rs * gv.x, v[j].y * rs * gv.y); w.y = pk2(v[j].z * rs * gv.z, v[j].w * rs * gv.w); o8[64 * j] = w; }
}
__device__ __forceinline__ void rms_rowbf_to_bf16(const bf16_t* hrow, const float* g, bf16_t* orow, int lane) {
    const u32x4 a = *(const u32x4*)(hrow + 16 * lane), b = *(const u32x4*)(hrow + 16 * lane + 8);
    float v[16];
    v[0] = bflo(a.x); v[1] = bfhi(a.x); v[2] = bflo(a.y); v[3] = bfhi(a.y); v[4] = bflo(a.z); v[5] = bfhi(a.z); v[6] = bflo(a.w); v[7] = bfhi(a.w);
    v[8] = bflo(b.x); v[9] = bfhi(b.x); v[10] = bflo(b.y); v[11] = bfhi(b.y); v[12] = bflo(b.z); v[13] = bfhi(b.z); v[14] = bflo(b.w); v[15] = bfhi(b.w);
    float s = 0.f;
#pragma unroll
    for (int e = 0; e < 16; ++e) s += v[e] * v[e];
    const float rs = rsqrtf(wave_sum(s) * (1.0f / 1024.0f) + 1e-6f);
    const f32x4 g0 = *(const f32x4*)(g + 16 * lane), g1 = *(const f32x4*)(g + 16 * lane + 4), g2 = *(const f32x4*)(g + 16 * lane + 8), g3 = *(const f32x4*)(g + 16 * lane + 12);
    u32x4 w0, w1;
    w0.x = pk2(v[0] * rs * g0.x, v[1] * rs * g0.y); w0.y = pk2(v[2] * rs * g0.z, v[3] * rs * g0.w); w0.z = pk2(v[4] * rs * g1.x, v[5] * rs * g1.y); w0.w = pk2(v[6] * rs * g1.z, v[7] * rs * g1.w);
    w1.x = pk2(v[8] * rs * g2.x, v[9] * rs * g2.y); w1.y = pk2(v[10] * rs * g2.z, v[11] * rs * g2.w); w1.z = pk2(v[12] * rs * g3.x, v[13] * rs * g3.y); w1.w = pk2(v[14] * rs * g3.z, v[15] * rs * g3.w);
    *(u32x4*)(orow + 16 * lane) = w0; *(u32x4*)(orow + 16 * lane + 8) = w1;
}
__device__ __forceinline__ void rms_rowbf_to_bf16_q(const bf16_t* hrow, const float* g, bf16_t* orow, unsigned char* xq, float* xs, int lane) {
    const u32x4 a = *(const u32x4*)(hrow + 16 * lane), b = *(const u32x4*)(hrow + 16 * lane + 8);
    float v[16];
    v[0] = bflo(a.x); v[1] = bfhi(a.x); v[2] = bflo(a.y); v[3] = bfhi(a.y); v[4] = bflo(a.z); v[5] = bfhi(a.z); v[6] = bflo(a.w); v[7] = bfhi(a.w);
    v[8] = bflo(b.x); v[9] = bfhi(b.x); v[10] = bflo(b.y); v[11] = bfhi(b.y); v[12] = bflo(b.z); v[13] = bfhi(b.z); v[14] = bflo(b.w); v[15] = bfhi(b.w);
    float s = 0.f;
#pragma unroll
    for (int e = 0; e < 16; ++e) s += v[e] * v[e];
    const float rs = rsqrtf(wave_sum(s) * (1.0f / 1024.0f) + 1e-6f);
    const f32x4 g0 = *(const f32x4*)(g + 16 * lane), g1 = *(const f32x4*)(g + 16 * lane + 4), g2 = *(const f32x4*)(g + 16 * lane + 8), g3 = *(const f32x4*)(g + 16 * lane + 12);
    v[0] *= rs * g0.x; v[1] *= rs * g0.y; v[2] *= rs * g0.z; v[3] *= rs * g0.w; v[4] *= rs * g1.x; v[5] *= rs * g1.y; v[6] *= rs * g1.z; v[7] *= rs * g1.w;
    v[8] *= rs * g2.x; v[9] *= rs * g2.y; v[10] *= rs * g2.z; v[11] *= rs * g2.w; v[12] *= rs * g3.x; v[13] *= rs * g3.y; v[14] *= rs * g3.z; v[15] *= rs * g3.w;
    u32x4 w0, w1;
    w0.x = pk2(v[0], v[1]); w0.y = pk2(v[2], v[3]); w0.z = pk2(v[4], v[5]); w0.w = pk2(v[6], v[7]);
    w1.x = pk2(v[8], v[9]); w1.y = pk2(v[10], v[11]); w1.z = pk2(v[12], v[13]); w1.w = pk2(v[14], v[15]);
    *(u32x4*)(orow + 16 * lane) = w0; *(u32x4*)(orow + 16 * lane + 8) = w1;
    float mx = 0.f;
#pragma unroll
    for (int e = 0; e < 16; ++e) mx = fmaxf(mx, fabsf(v[e]));
#pragma unroll
    for (int o = 1; o < 64; o <<= 1) mx = fmaxf(mx, __shfl_xor(mx, o));
    mx = fmaxf(mx, 1e-30f);
    const float xinv = 127.0f / mx;
    u32x4 q;
#pragma unroll
    for (int j = 0; j < 4; ++j) { const int a_ = (int)rintf(v[4 * j] * xinv), b_ = (int)rintf(v[4 * j + 1] * xinv), c_ = (int)rintf(v[4 * j + 2] * xinv), d_ = (int)rintf(v[4 * j + 3] * xinv);
        q[j] = (unsigned)(a_ & 255) | ((unsigned)(b_ & 255) << 8) | ((unsigned)(c_ & 255) << 16) | ((unsigned)(d_ & 255) << 24); }
    *(u32x4*)(xq + 16 * lane) = q;
    if (lane == 0) *xs = mx * (1.0f / 127.0f);
}
__device__ __forceinline__ void convert_f32_bf16(const float* src, bf16_t* dst, size_t n4, size_t gtid, size_t gn) {
    for (size_t i = gtid; i < n4; i += gn) { const f32x4 v = ((const f32x4*)src)[i]; u32x2 w; w.x = pk2(v.x, v.y); w.y = pk2(v.z, v.w); ((u32x2*)dst)[i] = w; }
}

__device__ __forceinline__ void p0_prep(const Params& P, unsigned char* ws, LAS unsigned char* lds, int gw, int NGW, int lane, int wave) {
    LAS float* scr = (LAS float*)(lds + wave * 16384);
    constexpr int I_IN = 16 * 320, I_SQ = 16 * 32, I_Q = 16 * 64, NIT = I_IN + 3 * I_SQ + I_Q;
    for (int it = gw; it < NIT; it += NGW) {
        int r = it;
        if (r < I_IN) { transpose_item(P.in[2], 1024, 10240, (bf16_t*)(ws + WS_WIN), scr, r, lane, true); continue; } r -= I_IN;
        if (r < I_SQ) { transpose_item(P.in[16], 1024, 1024, (bf16_t*)(ws + WS_WA), scr, r, lane); continue; } r -= I_SQ;
        if (r < I_SQ) { transpose_item(P.in[17], 1024, 1024, (bf16_t*)(ws + WS_WB), scr, r, lane); continue; } r -= I_SQ;
        if (r < I_SQ) { transpose_item(P.in[18], 1024, 1024, (bf16_t*)(ws + WS_WO), scr, r, lane); continue; } r -= I_SQ;
        transpose_item(P.in[20], 1024, 2048, (bf16_t*)(ws + WS_WQ), scr, r, lane);
    }
    convert_f32_bf16(P.in[21], (bf16_t*)(ws + WS_SK), 262144 / 4, (size_t)gw * 64 + lane, (size_t)NGW * 64);
    bf16_t* XN = (bf16_t*)(ws + WS_XN);
#pragma unroll 2
    for (int m = gw; m < T_; m += NGW) rms_row_to_bf16(P.in[0] + (size_t)m * D_, P.in[1], XN + (size_t)m * D_, lane);
    float* HID = (float*)(ws + WS_HID);
    const float* w1 = P.in[7]; const float* b1 = P.in[8]; const float* f1 = P.in[9]; const float* w2 = P.in[10]; const float* b2 = P.in[11]; const float* f2 = P.in[12];
    for (int n = gw; n < L_; n += NGW) {
        const float pos = (float)n, t = pos / 8191.0f;
        float zv = 0.f;
        if (lane == 0) zv = t;
        else if (lane <= 32) { const int bi = (lane - 1) & 15; const float band = 1e-4f + (float)bi * ((15.0f - 1e-4f) / 15.0f);
            const float ang = ((float)(2.0 * 3.14159265358979323846 / 8192.0) * pos) * band;
            zv = lane <= 16 ? cosf(ang) : -sinf(ang); }
        float h = 0.f;
#pragma unroll 3
        for (int i = 0; i < 33; ++i) h += __shfl(zv, i) * w1[i * 64 + lane];
        h = sinf(f1[lane] * (h + b1[lane]));
        float h2 = 0.f;
#pragma unroll 8
        for (int i = 0; i < 64; ++i) h2 += __shfl(h, i) * w2[i * 64 + lane];
        h2 = sinf(f2[lane] * (h2 + b2[lane]));
        HID[n * 64 + lane] = h2;
    }
}

__device__ __forceinline__ f32x16 mfma32(bf16x8 a, bf16x8 b, f32x16 c) { return __builtin_amdgcn_mfma_f32_32x32x16_bf16(a, b, c, 0, 0, 0); }
__device__ __forceinline__ f32x4 mfma16(bf16x8 a, bf16x8 b, f32x4 c) { return __builtin_amdgcn_mfma_f32_16x16x32_bf16(a, b, c, 0, 0, 0); }
__device__ __forceinline__ bf16x8 pack8(const float (&f)[8]) { u32x4 w; w.x = pk2(f[0], f[1]); w.y = pk2(f[2], f[3]); w.z = pk2(f[4], f[5]); w.w = pk2(f[6], f[7]); return __builtin_bit_cast(bf16x8, w); }
__device__ __forceinline__ void p1_filt(const Params& P, const float* HID, float* FILT, int tid, int bid) {
    const float* w3 = P.in[13]; const float* decay = P.in[14]; const float* bias = P.in[15];
    const int lane = tid & 63, wave = tid >> 6, r32 = lane & 31, hh = lane >> 5;
    for (int item = bid; item < 256; item += gridDim.x) {
        const int nb = item >> 4, cb = item & 15;
        bf16x8 bw[4][4]; float dec[4], bs[4];
#pragma unroll
        for (int cblk = 0; cblk < 4; ++cblk) { const int c = cb * 128 + 32 * cblk + r32;
            dec[cblk] = fabsf(decay[c]); bs[cblk] = (c < 1024) ? bias[c] : 0.f;
#pragma unroll
            for (int ks = 0; ks < 4; ++ks) { float f[8];
#pragma unroll
                for (int jj = 0; jj < 8; ++jj) f[jj] = w3[(16 * ks + 8 * hh + jj) * 2048 + c];
                bw[cblk][ks] = pack8(f); } }
#pragma unroll 1
        for (int q = 0; q < 2; ++q) {
            const int n0 = nb * 512 + (wave * 2 + q) * 32;
            bf16x8 af[4];
#pragma unroll
            for (int ks = 0; ks < 4; ++ks) { const f32x4* hp = (const f32x4*)(HID + (size_t)(n0 + r32) * 64 + 16 * ks + 8 * hh); const f32x4 a = hp[0], b = hp[1];
                float f[8] = {a.x, a.y, a.z, a.w, b.x, b.y, b.z, b.w}; af[ks] = pack8(f); }
#pragma unroll
            for (int cblk = 0; cblk < 4; ++cblk) {
                f32x16 acc;
#pragma unroll
                for (int e = 0; e < 16; ++e) acc[e] = 0.f;
#pragma unroll
                for (int ks = 0; ks < 4; ++ks) acc = mfma32(af[ks], bw[cblk][ks], acc);
                const int c = cb * 128 + 32 * cblk + r32;
#pragma unroll
                for (int g = 0; g < 4; ++g) {
                    const int nbase = n0 + 8 * g + 4 * hh;
                    float v[4];
#pragma unroll
                    for (int e = 0; e < 4; ++e) { const float t = (float)(nbase + e) / 8191.0f; v[e] = acc[4 * g + e] * __expf(-t * dec[cblk]); }
                    if (cb < 8) {
                        if (nbase == 0) v[0] += bs[cblk];
                        f32x4 o = {v[0], v[1], v[2], v[3]}; *(f32x4*)(FILT + (size_t)c * 16384 + nbase) = o;
                    } else {
                        float* row = FILT + (size_t)(c - 1024) * 16384;
                        if (nbase == 0) { row[16383] = v[1]; row[16382] = v[2]; row[16381] = v[3]; row[8192] = 0.f; }
                        else { f32x4 o = {v[3], v[2], v[1], v[0]}; *(f32x4*)(row + 16384 - nbase - 3) = o; }
                    }
                }
            }
        }
    }
}

__device__ __forceinline__ void unpack4(u32x2 w, float (&f)[4]) { f[0] = bflo(w.x); f[1] = bfhi(w.x); f[2] = bflo(w.y); f[3] = bfhi(w.y); }
__device__ __forceinline__ void p2_conv(const Params& P, const bf16_t* X0, const bf16_t* X1, const bf16_t* XV, bf16_t* UT, bf16_t* X0C, LAS unsigned char* lds, int gw, int NGW, int lane, int wave) {
    LAS bf16_t* tile = (LAS bf16_t*)(lds + wave * 9216);
    const float* cw = P.in[5]; const float* cb = P.in[6];
    const int cq = lane & 15, rg = lane >> 4;
    for (int tl = gw; tl < 8192; tl += NGW) {
        const int ct = tl & 15, tt = tl >> 4, b = tt >> 7, t0 = (tt & 127) * 64, c = ct * 64 + 4 * cq;
        const size_t rowb = (size_t)b * L_;
        u32x2 r0[18], r1[18], r2[18];
#pragma unroll
        for (int i = 0; i < 18; ++i) { const int t = t0 + 16 * rg + i - 1; const bool ok = (t >= 0) && (t < L_); const size_t o = (rowb + (ok ? t : 0)) * 1024 + c;
            const u32x2 z = {0u, 0u};
            r0[i] = ok ? *(const u32x2*)(X0 + o) : z; r1[i] = ok ? *(const u32x2*)(X1 + o) : z; r2[i] = ok ? *(const u32x2*)(XV + o) : z; }
        f32x4 w0[3], w1[3], w2[3];
#pragma unroll
        for (int jj = 0; jj < 3; ++jj) { w0[jj] = *(const f32x4*)(cw + jj * 3072 + c); w1[jj] = *(const f32x4*)(cw + jj * 3072 + 1024 + c); w2[jj] = *(const f32x4*)(cw + jj * 3072 + 2048 + c); }
        const f32x4 bb0 = *(const f32x4*)(cb + c), bb1 = *(const f32x4*)(cb + 1024 + c), bb2 = *(const f32x4*)(cb + 2048 + c);
        float uu[4][16];
#pragma unroll
        for (int i = 0; i < 16; ++i) {
            float a[4], bq[4], cc[4], x0o[4];
            float m0[4], m1[4], m2[4];
            unpack4(r0[i], a); unpack4(r0[i + 1], bq); unpack4(r0[i + 2], cc);
#pragma unroll
            for (int e = 0; e < 4; ++e) x0o[e] = bb0[e] + w0[0][e] * a[e] + w0[1][e] * bq[e] + w0[2][e] * cc[e];
            unpack4(r1[i], a); unpack4(r1[i + 1], bq); unpack4(r1[i + 2], cc);
#pragma unroll
            for (int e = 0; e < 4; ++e) m1[e] = bb1[e] + w1[0][e] * a[e] + w1[1][e] * bq[e] + w1[2][e] * cc[e];
            unpack4(r2[i], a); unpack4(r2[i + 1], bq); unpack4(r2[i + 2], cc);
#pragma unroll
            for (int e = 0; e < 4; ++e) { m2[e] = bb2[e] + w2[0][e] * a[e] + w2[1][e] * bq[e] + w2[2][e] * cc[e]; uu[e][i] = m2[e] * m1[e]; }
            (void)m0;
            u32x2 xo; xo.x = pk2(x0o[0], x0o[1]); xo.y = pk2(x0o[2], x0o[3]);
            *(u32x2*)(X0C + (rowb + t0 + 16 * rg + i) * 1024 + c) = xo;
        }
#pragma unroll
        for (int e = 0; e < 4; ++e) {
            u32x4 wa, wb;
            wa.x = pk2(uu[e][0], uu[e][1]); wa.y = pk2(uu[e][2], uu[e][3]); wa.z = pk2(uu[e][4], uu[e][5]); wa.w = pk2(uu[e][6], uu[e][7]);
            wb.x = pk2(uu[e][8], uu[e][9]); wb.y = pk2(uu[e][10], uu[e][11]); wb.z = pk2(uu[e][12], uu[e][13]); wb.w = pk2(uu[e][14], uu[e][15]);
            LAS u32x4* dst = (LAS u32x4*)(tile + (4 * cq + e) * 72 + 16 * rg); dst[0] = wa; dst[1] = wb;
        }
        LDS_WAIT();
#pragma unroll
        for (int cc = 0; cc < 16; ++cc) { const int cl = 4 * cc + rg;
            const u32x2 v = *(const LAS u32x2*)(tile + cl * 72 + 4 * cq);
            *(u32x2*)(UT + ((size_t)(ct * 64 + cl) * 4 + b) * L_ + t0 + 4 * cq) = v; }
        LDS_WAIT();
    }
}

__device__ __forceinline__ int fft_salt() { int z; asm volatile("v_mov_b32 %0, 0" : "=v"(z)); return z; }
__device__ __forceinline__ void p3_fft(const float* FILT, bf16_t* UT, cf2* KBUF, LAS unsigned char* lds, int tid, int bid) {
    LAS cf2* F = (LAS cf2*)lds;
    cf2* KB = KBUF + (size_t)bid * (32 * 512) + tid;
    for (int ch = bid; ch < 1024; ch += gridDim.x) {
        const float* kf = FILT + (size_t)ch * 16384;
#pragma unroll 1
        for (int h = 0; h < 2; ++h) { const int rr = tid + 512 * h; float re[16], im[16];
#pragma unroll
            for (int j = 0; j < 16; ++j) { re[j] = kf[1024 * j + rr]; im[j] = 0.f; }
            fft_fwd_p1(re, im, rr, F, fft_salt()); }
        __syncthreads();
        fft_fwd_p2(tid, F, fft_salt());
        __syncthreads();
        { float re[32], im[32];
          fft_fwd_p3(tid, F, re, im);
#pragma unroll
          for (int j = 0; j < 32; ++j) { cf2 kv; kv.x = re[j] * (1.0f / 16384.0f); kv.y = im[j] * (1.0f / 16384.0f); KB[j * 512] = kv; } }
        __syncthreads();
#pragma unroll 1
        for (int pr = 0; pr < 2; ++pr) {
            bf16_t* u0 = UT + ((size_t)ch * 4 + 2 * pr) * L_; bf16_t* u1 = u0 + L_;
#pragma unroll 1
            for (int h = 0; h < 2; ++h) { const int rr = tid + 512 * h; float re[16], im[16];
#pragma unroll
                for (int j = 0; j < 8; ++j) { re[j] = bf2f(u0[1024 * j + rr]); im[j] = bf2f(u1[1024 * j + rr]); }
#pragma unroll
                for (int j = 8; j < 16; ++j) { re[j] = 0.f; im[j] = 0.f; }
                fft_fwd_p1(re, im, rr, F, fft_salt()); }
            __syncthreads();
            fft_fwd_p2(tid, F, fft_salt());
            __syncthreads();
            { float re[32], im[32];
              fft_fwd_p3(tid, F, re, im);
#pragma unroll
              for (int j = 0; j < 32; ++j) { const cf2 kv = KB[j * 512]; const float a = re[j], b = im[j]; re[j] = a * kv.x - b * kv.y; im[j] = a * kv.y + b * kv.x; }
              fft_inv_p3(tid, F, re, im, fft_salt()); }
            __syncthreads();
            fft_inv_p2(tid, F, fft_salt());
            __syncthreads();
#pragma unroll 1
            for (int h = 0; h < 2; ++h) { const int rr = tid + 512 * h + fft_salt(); float re[16], im[16];
                fft_inv_p1(re, im, rr, F);
#pragma unroll
                for (int j = 0; j < 8; ++j) { u0[1024 * j + rr] = f2bf(re[j]); u1[1024 * j + rr] = f2bf(im[j]); } }
        }
        __syncthreads();
    }
}

__device__ __forceinline__ void p4_yb(const bf16_t* UT, bf16_t* X0C, LAS unsigned char* lds, int gw, int NGW, int lane, int wave) {
    LAS bf16_t* tile = (LAS bf16_t*)(lds + wave * 9216);
    const int cq = lane & 15, rg = lane >> 4;
    for (int tl = gw; tl < 8192; tl += NGW) {
        const int ct = tl & 15, tt = tl >> 4, b = tt >> 7, t0 = (tt & 127) * 64;
#pragma unroll
        for (int cc = 0; cc < 16; ++cc) { const int cl = 4 * cc + rg;
            *(LAS u32x2*)(tile + cl * 72 + 4 * cq) = *(const u32x2*)(UT + ((size_t)(ct * 64 + cl) * 4 + b) * L_ + t0 + 4 * cq); }
        LDS_WAIT();
        u32x4 cv[4][2];
#pragma unroll
        for (int e = 0; e < 4; ++e) { const LAS u32x4* src = (const LAS u32x4*)(tile + (4 * cq + e) * 72 + 16 * rg); cv[e][0] = src[0]; cv[e][1] = src[1]; }
#pragma unroll
        for (int i = 0; i < 16; ++i) {
            const size_t o = ((size_t)b * L_ + t0 + 16 * rg + i) * 1024 + ct * 64 + 4 * cq;
            const u32x2 xv = *(const u32x2*)(X0C + o);
            float cf[4];
#pragma unroll
            for (int e = 0; e < 4; ++e) { const unsigned w = cv[e][i >> 3][(i >> 1) & 3]; cf[e] = (i & 1) ? bfhi(w) : bflo(w); }
            u32x2 yo; yo.x = pk2(bflo(xv.x) * cf[0], bfhi(xv.x) * cf[1]); yo.y = pk2(bflo(xv.y) * cf[2], bfhi(xv.y) * cf[3]);
            *(u32x2*)(X0C + o) = yo;
        }
        LDS_WAIT();
    }
}

__device__ __forceinline__ void p6a_prep(const Params& P, bf16_t* QF, bf16_t* KF, bf16_t* KB, bf16_t* QB, float* FACG, LAS unsigned char* lds, int tid, int bid) {
    LAS float* SEGF = (LAS float*)lds; LAS float* SEGB = SEGF + 1024;
    const float* lbl = P.in[3];
    const int k2 = (tid & 63) * 2, seg = tid >> 6;
    for (int unit = bid; unit < 4096; unit += gridDim.x) {
        const int c = unit & 127, h = (unit >> 7) & 7, b = unit >> 10;
        const float lbk0 = 1.0f / (1.0f + __expf(lbl[1024 + h * 128 + k2] - lbl[h * 128 + k2])), lbk1 = 1.0f / (1.0f + __expf(lbl[1024 + h * 128 + k2 + 1] - lbl[h * 128 + k2 + 1]));
        const float omlb0 = 1.0f - lbk0, omlb1 = 1.0f - lbk1;
        const size_t e0 = ((size_t)b * L_ + 64 * c + 8 * seg) * 1024 + h * 128 + k2;
        unsigned qv[8], zf[8], zb[8];
#pragma unroll
        for (int ii = 0; ii < 8; ++ii) { qv[ii] = *(const unsigned*)(QF + e0 + (size_t)ii * 1024); zf[ii] = *(const unsigned*)(KF + e0 + (size_t)ii * 1024); zb[ii] = *(const unsigned*)(KB + e0 + (size_t)ii * 1024); }
        float cf0[8], cf1[8], cb0[8], cb1[8], kf0[8], kf1[8], kb0[8], kb1[8];
        { float r0 = 1.f, r1 = 1.f;
#pragma unroll
          for (int ii = 0; ii < 8; ++ii) { const float f0 = lbk0 + omlb0 * __builtin_amdgcn_rcpf(1.0f + __expf(-bflo(zf[ii]))), f1 = lbk1 + omlb1 * __builtin_amdgcn_rcpf(1.0f + __expf(-bfhi(zf[ii])));
              r0 *= f0; r1 *= f1; cf0[ii] = r0; cf1[ii] = r1; kf0[ii] = 1.0f - f0; kf1[ii] = 1.0f - f1; }
          cf2 sv; sv.x = r0; sv.y = r1; *(LAS cf2*)(SEGF + seg * 128 + k2) = sv; }
        { float r0 = 1.f, r1 = 1.f;
#pragma unroll
          for (int ii = 7; ii >= 0; --ii) { const float f0 = lbk0 + omlb0 * __builtin_amdgcn_rcpf(1.0f + __expf(-bflo(zb[ii]))), f1 = lbk1 + omlb1 * __builtin_amdgcn_rcpf(1.0f + __expf(-bfhi(zb[ii])));
              r0 *= f0; r1 *= f1; cb0[ii] = r0; cb1[ii] = r1; kb0[ii] = 1.0f - f0; kb1[ii] = 1.0f - f1; }
          cf2 sv; sv.x = r0; sv.y = r1; *(LAS cf2*)(SEGB + seg * 128 + k2) = sv; }
        __syncthreads();
        float pf0 = 1.f, pf1 = 1.f, rf0 = 1.f, rf1 = 1.f, lf0 = 1.f, lf1 = 1.f, pb0 = 1.f, pb1 = 1.f, rb0 = 1.f, rb1 = 1.f, lb0 = 1.f, lb1 = 1.f;
#pragma unroll
        for (int s = 0; s < 8; ++s) { const cf2 a = *(const LAS cf2*)(SEGF + s * 128 + k2), bq = *(const LAS cf2*)(SEGB + s * 128 + k2);
            if (s < seg) { pf0 *= a.x; pf1 *= a.y; } if (s < 4) { rf0 *= a.x; rf1 *= a.y; } lf0 *= a.x; lf1 *= a.y;
            if (s > seg) { pb0 *= bq.x; pb1 *= bq.y; } if (s >= 4) { rb0 *= bq.x; rb1 *= bq.y; } lb0 *= bq.x; lb1 *= bq.y; }
        const float irf0 = __builtin_amdgcn_rcpf(rf0), irf1 = __builtin_amdgcn_rcpf(rf1), irb0 = __builtin_amdgcn_rcpf(rb0), irb1 = __builtin_amdgcn_rcpf(rb1);
        const float sf0 = pf0 * irf0, sf1 = pf1 * irf1, sb0 = pb0 * irb0, sb1 = pb1 * irb1;
#pragma unroll
        for (int ii = 0; ii < 8; ++ii) {
            const float q0 = bflo(qv[ii]), q1 = bfhi(qv[ii]);
            const float ef0 = sf0 * cf0[ii], ef1 = sf1 * cf1[ii], eb0 = sb0 * cb0[ii], eb1 = sb1 * cb1[ii];
            const size_t o = e0 + (size_t)ii * 1024;
            *(unsigned*)(QF + o) = pk2(q0 * ef0, q1 * ef1);
            *(unsigned*)(KF + o) = pk2(kf0[ii] * __builtin_amdgcn_rcpf(ef0), kf1[ii] * __builtin_amdgcn_rcpf(ef1));
            *(unsigned*)(QB + o) = pk2(q0 * eb0, q1 * eb1);
            *(unsigned*)(KB + o) = pk2(kb0[ii] * __builtin_amdgcn_rcpf(eb0), kb1[ii] * __builtin_amdgcn_rcpf(eb1));
        }
        if (seg == 0) {
            float* ff = FACG + ((size_t)((0 * 4 + b) * 8 + h) * 128 + c) * 384; float* fb = FACG + ((size_t)((1 * 4 + b) * 8 + h) * 128 + (127 - c)) * 384;
            cf2 w; w.x = rf0; w.y = rf1; *(cf2*)(ff + k2) = w; w.x = lf0; w.y = lf1; *(cf2*)(ff + 128 + k2) = w; w.x = lf0 * irf0; w.y = lf1 * irf1; *(cf2*)(ff + 256 + k2) = w;
            w.x = rb0; w.y = rb1; *(cf2*)(fb + k2) = w; w.x = lb0; w.y = lb1; *(cf2*)(fb + 128 + k2) = w; w.x = lb0 * irb0; w.y = lb1 * irb1; *(cf2*)(fb + 256 + k2) = w;
        }
        __syncthreads();
    }
}

__device__ __forceinline__ void p6b_scan(const bf16_t* QF, const bf16_t* KF, const bf16_t* KB, const bf16_t* QB, const bf16_t* VV, const float* FACG, bf16_t* OF, bf16_t* OB, LAS unsigned char* lds, int tid, int lane, int wid, int bid) {
    constexpr int SETB = 41472;
    LAS bf16_t* ST = (LAS bf16_t*)(lds + 2 * SETB);
    LAS bf16_t* PT = ST + 32 * 136;
    const int fr = lane & 15, fq = lane >> 4;
    LAS bf16_t* OT = PT + 64 * 72;
    const int r32 = lane & 31, hh = lane >> 5;
    for (int unit_ = bid; unit_ < 256; unit_ += gridDim.x) {
        const int unit = (gridDim.x == 256) ? ((((unit_ & 7) * 8 + (unit_ >> 5)) << 2) | ((unit_ >> 3) & 3)) : unit_;
        const int dir = unit >> 7, b = (unit >> 5) & 3, h = (unit >> 2) & 7, vs = unit & 3;
        const bf16_t* Qg = dir ? QB : QF; const bf16_t* Kg = dir ? KB : KF; bf16_t* O = dir ? OB : OF;
        const float* Fg = FACG + (size_t)((dir * 4 + b) * 8 + h) * 128 * 384;
        const size_t ubase = (size_t)b * L_ * 1024 + h * 128;
        const unsigned po0 = (unsigned)(((tid >> 4) * 1024 + (tid & 15) * 8) * 2), po1 = po0 + 32 * 1024 * 2;
        const unsigned pv = (unsigned)((((tid & 255) >> 2) * 1024 + (tid & 3) * 8) * 2);
        f32x4 S[2];
        S[0] = (f32x4){0.f, 0.f, 0.f, 0.f}; S[1] = S[0];
        u32x4 qA0, qA1, kA0, kA1, vA, fA, qB0, qB1, kB0, kB1, vB, fB, qC0, qC1, kC0, kC1, vC, fC, qD0, qD1, kD0, kD1, vD, fD;
#define HS_TROW(cc) (dir ? (127 - (cc)) * 64 : (cc) * 64)
#define HS_LOAD(cc, q0, q1, k0, k1, vv, ff) do { const int cc_ = (cc) < 128 ? (cc) : 127; \
            const size_t tb_ = ubase + (size_t)__builtin_amdgcn_readfirstlane(HS_TROW(cc_)) * 1024; \
            const char* qp_ = (const char*)(Qg + tb_); const char* kp_ = (const char*)(Kg + tb_); const char* vp_ = (const char*)(VV + tb_ + vs * 32); \
            q0 = *(const u32x4*)(qp_ + po0); q1 = *(const u32x4*)(qp_ + po1); k0 = *(const u32x4*)(kp_ + po0); k1 = *(const u32x4*)(kp_ + po1); \
            vv = *(const u32x4*)(vp_ + pv); ff = *(const u32x4*)(Fg + (size_t)cc_ * 384 + 4 * (tid < 96 ? tid : 0)); } while (0)
#define HS_STORE(sb, q0, q1, k0, k1, vv, ff) do { LAS bf16_t* QT_ = (LAS bf16_t*)(lds + (sb) * SETB); LAS bf16_t* KT_ = QT_ + 64 * 136; LAS bf16_t* VR_ = KT_ + 64 * 136; LAS float* FAC_ = (LAS float*)(VR_ + 64 * 40); \
            const int s0_ = tid >> 4, ck_ = (tid & 15) * 8; \
            *(LAS u32x4*)(QT_ + s0_ * 136 + ck_) = q0; *(LAS u32x4*)(QT_ + (s0_ + 32) * 136 + ck_) = q1; \
            *(LAS u32x4*)(KT_ + s0_ * 136 + ck_) = k0; *(LAS u32x4*)(KT_ + (s0_ + 32) * 136 + ck_) = k1; \
            if (tid < 256) *(LAS u32x4*)(VR_ + (tid >> 2) * 40 + (tid & 3) * 8) = vv; \
            if (tid < 96) *(LAS u32x4*)(FAC_ + 4 * tid) = ff; } while (0)
#define HS_TR8(img, stride, row0, col0) __builtin_shufflevector( \
            __builtin_amdgcn_ds_read_tr16_b64_v4i16((LAS v4i16_t*)((img) + ((row0) + (fr >> 2)) * (stride) + (col0) + 4 * (fr & 3))), \
            __builtin_amdgcn_ds_read_tr16_b64_v4i16((LAS v4i16_t*)((img) + ((row0) + 4 + (fr >> 2)) * (stride) + (col0) + 4 * (fr & 3))), 0, 1, 2, 3, 4, 5, 6, 7)
#define HS_FLUSH(cc, par) do { const u32x2 ov_ = *(const LAS u32x2*)(OT + (par) * 2048 + 4 * tid); \
            *(u32x2*)(O + ubase + ((size_t)__builtin_amdgcn_readfirstlane(HS_TROW(cc)) + (tid >> 3)) * 1024 + vs * 32 + 4 * (tid & 7)) = ov_; } while (0)
#define HS_ITER(c, X0, X1, X2, X3, X4, X5, Y0, Y1, Y2, Y3, Y4, Y5) do { \
            const int cur = (c) & 1; \
            LAS bf16_t* QT = (LAS bf16_t*)(lds + cur * SETB); LAS bf16_t* KT = QT + 64 * 136; LAS bf16_t* VR = KT + 64 * 136; LAS float* FAC = (LAS float*)(VR + 64 * 40); \
            HS_STORE(cur ^ 1, X0, X1, X2, X3, X4, X5); \
            HS_FLUSH(((c) > 0 ? (c) - 1 : 0), (cur ^ 1));     \
            HS_LOAD((c) + 5, X0, X1, X2, X3, X4, X5);     \
              \
            { const f32x4 fc = *(const LAS f32x4*)(FAC + 16 * wid + 4 * fq); \
              _Pragma("unroll") for (int vt = 0; vt < 2; ++vt) { u32x2 w; w.x = pk2(S[vt][0] * fc[0], S[vt][1] * fc[1]); w.y = pk2(S[vt][2] * fc[2], S[vt][3] * fc[3]); \
                  *(LAS u32x2*)(ST + (16 * vt + fr) * 136 + 16 * wid + 4 * fq) = w; } } \
            bf16x8 qa[4];        \
            { const int ti = wid >> 1; \
              _Pragma("unroll") for (int ks = 0; ks < 4; ++ks) qa[ks] = *(const LAS bf16x8*)(QT + (16 * ti + fr) * 136 + 32 * ks + 8 * fq); \
              _Pragma("unroll") for (int tq = 0; tq < 2; ++tq) { const int tj = 2 * (wid & 1) + tq; f32x4 acc = {0.f, 0.f, 0.f, 0.f}; \
                  if (dir ? (tj >= ti) : (tj <= ti)) {       \
                  _Pragma("unroll") for (int ks = 0; ks < 4; ++ks) { const bf16x8 bb = *(const LAS bf16x8*)(KT + (16 * tj + fr) * 136 + 32 * ks + 8 * fq); acc = mfma16(qa[ks], bb, acc); } } \
                  _Pragma("unroll") for (int r = 0; r < 4; ++r) { const int i = 16 * ti + 4 * fq + r, s = 16 * tj + fr; const bool keep = dir ? (s >= i) : (s <= i); PT[i * 72 + s] = f2bf(keep ? acc[r] : 0.f); } } } \
            __syncthreads(); \
              \
            { const int it = wid >> 1, vt = wid & 1; f32x4 acc = {0.f, 0.f, 0.f, 0.f}; \
              bf16x8 vb[2][2]; \
              _Pragma("unroll") for (int k2 = 0; k2 < 2; ++k2) { vb[0][k2] = HS_TR8(VR, 40, 32 * k2 + 8 * fq, 0); vb[1][k2] = HS_TR8(VR, 40, 32 * k2 + 8 * fq, 16); } \
              _Pragma("unroll") for (int ks = 0; ks < 4; ++ks) { const bf16x8 bb = *(const LAS bf16x8*)(ST + (16 * vt + fr) * 136 + 32 * ks + 8 * fq); acc = mfma16(qa[ks], bb, acc); } \
              _Pragma("unroll") for (int k2 = 0; k2 < 2; ++k2) { const bf16x8 a = *(const LAS bf16x8*)(PT + (16 * it + fr) * 72 + 32 * k2 + 8 * fq); const bf16x8 bi = HS_TR8(VR, 40, 32 * k2 + 8 * fq, 16 * vt); acc = mfma16(a, bi, acc); } \
              _Pragma("unroll") for (int r = 0; r < 4; ++r) OT[cur * 2048 + (16 * it + 4 * fq + r) * 32 + 16 * vt + fr] = f2bf(acc[r]); \
              const f32x4 f1 = *(const LAS f32x4*)(FAC + 128 + 16 * wid + 4 * fq), f2 = *(const LAS f32x4*)(FAC + 256 + 16 * wid + 4 * fq); \
              bf16x8 ka[2]; \
              _Pragma("unroll") for (int k2 = 0; k2 < 2; ++k2) ka[k2] = HS_TR8(KT, 136, 32 * k2 + 8 * fq, 16 * wid); \
              _Pragma("unroll") for (int v2 = 0; v2 < 2; ++v2) { f32x4 d = {0.f, 0.f, 0.f, 0.f}; \
                  _Pragma("unroll") for (int k2 = 0; k2 < 2; ++k2) d = mfma16(ka[k2], vb[v2][k2], d); \
                  _Pragma("unroll") for (int r = 0; r < 4; ++r) S[v2][r] = f1[r] * S[v2][r] + f2[r] * d[r]; } } \
            __syncthreads(); } while (0)
        { u32x2 z_ = {0u, 0u}; *(LAS u32x2*)(OT + 2048 + 4 * tid) = z_; }
        HS_LOAD(0, qD0, qD1, kD0, kD1, vD, fD);
        HS_LOAD(1, qA0, qA1, kA0, kA1, vA, fA);
        HS_LOAD(2, qB0, qB1, kB0, kB1, vB, fB);
        HS_LOAD(3, qC0, qC1, kC0, kC1, vC, fC);
        HS_STORE(0, qD0, qD1, kD0, kD1, vD, fD);
        HS_LOAD(4, qD0, qD1, kD0, kD1, vD, fD);
        __syncthreads();
#pragma unroll 1
        for (int c = 0; c < 128; c += 4) {
            HS_ITER(c, qA0, qA1, kA0, kA1, vA, fA, qB0, qB1, kB0, kB1, vB, fB);
            HS_ITER(c + 1, qB0, qB1, kB0, kB1, vB, fB, qA0, qA1, kA0, kA1, vA, fA);
            HS_ITER(c + 2, qC0, qC1, kC0, kC1, vC, fC, qA0, qA1, kA0, kA1, vA, fA);
            HS_ITER(c + 3, qD0, qD1, kD0, kD1, vD, fD, qA0, qA1, kA0, kA1, vA, fA);
        }
        HS_FLUSH(127, 1);
        __syncthreads();
#undef HS_ITER
#undef HS_TR8
#undef HS_FLUSH
#undef HS_STORE
#undef HS_LOAD
#undef HS_TROW
    }
}

__device__ __forceinline__ void p7_aa(const Params& P, const bf16_t* OF, const bf16_t* OB, bf16_t* AA, int gw, int NGW, int lane) {
    const float* g = P.in[4];
#pragma unroll 2
    for (int m = gw; m < T_; m += NGW) {
        const size_t o = (size_t)m * 1024 + 16 * lane;
        const u32x4 f0 = *(const u32x4*)(OF + o), f1 = *(const u32x4*)(OF + o + 8), b0 = *(const u32x4*)(OB + o), b1 = *(const u32x4*)(OB + o + 8);
        float v[16];
        v[0] = bflo(f0.x) + bflo(b0.x); v[1] = bfhi(f0.x) + bfhi(b0.x); v[2] = bflo(f0.y) + bflo(b0.y); v[3] = bfhi(f0.y) + bfhi(b0.y);
        v[4] = bflo(f0.z) + bflo(b0.z); v[5] = bfhi(f0.z) + bfhi(b0.z); v[6] = bflo(f0.w) + bflo(b0.w); v[7] = bfhi(f0.w) + bfhi(b0.w);
        v[8] = bflo(f1.x) + bflo(b1.x); v[9] = bfhi(f1.x) + bfhi(b1.x); v[10] = bflo(f1.y) + bflo(b1.y); v[11] = bfhi(f1.y) + bfhi(b1.y);
        v[12] = bflo(f1.z) + bflo(b1.z); v[13] = bfhi(f1.z) + bfhi(b1.z); v[14] = bflo(f1.w) + bflo(b1.w); v[15] = bfhi(f1.w) + bfhi(b1.w);
        float ss = 0.f;
#pragma unroll
        for (int e = 0; e < 16; ++e) ss += v[e] * v[e];
        ss += __shfl_xor(ss, 1); ss += __shfl_xor(ss, 2); ss += __shfl_xor(ss, 4);
        const float rs = rsqrtf(ss * (1.0f / 128.0f) + 1e-6f);
        const float* gp = g + ((16 * lane) & 127);
#pragma unroll
        for (int e = 0; e < 16; ++e) v[e] = v[e] * rs * gp[e];
        u32x4 w0, w1; w0.x = pk2(v[0], v[1]); w0.y = pk2(v[2], v[3]); w0.z = pk2(v[4], v[5]); w0.w = pk2(v[6], v[7]); w1.x = pk2(v[8], v[9]); w1.y = pk2(v[10], v[11]); w1.z = pk2(v[12], v[13]); w1.w = pk2(v[14], v[15]);
        *(u32x4*)(AA + o) = w0; *(u32x4*)(AA + o + 8) = w1;
    }
}

__device__ __forceinline__ unsigned ordkey(float x) { const unsigned u = __float_as_uint(x); return u ^ ((u >> 31) ? 0xFFFFFFFFu : 0x80000000u); }
__device__ __forceinline__ float keyval(unsigned k) { return __uint_as_float(k ^ ((k >> 31) ? 0x80000000u : 0xFFFFFFFFu)); }
__device__ __forceinline__ unsigned dpp_ror(unsigned v, int n) {
    switch (n) { case 1: return (unsigned)__builtin_amdgcn_update_dpp(0, (int)v, 0x121, 0xF, 0xF, false);
                 case 2: return (unsigned)__builtin_amdgcn_update_dpp(0, (int)v, 0x122, 0xF, 0xF, false);
                 case 4: return (unsigned)__builtin_amdgcn_update_dpp(0, (int)v, 0x124, 0xF, 0xF, false);
                 default: return (unsigned)__builtin_amdgcn_update_dpp(0, (int)v, 0x128, 0xF, 0xF, false); }
}
__device__ __forceinline__ unsigned rowmax_u(unsigned m) { m = max(m, dpp_ror(m, 1)); m = max(m, dpp_ror(m, 2)); m = max(m, dpp_ror(m, 4)); m = max(m, dpp_ror(m, 8)); return m; }
__device__ __forceinline__ float rowsum_f(float m) {
    m += __uint_as_float(dpp_ror(__float_as_uint(m), 1)); m += __uint_as_float(dpp_ror(__float_as_uint(m), 2));
    m += __uint_as_float(dpp_ror(__float_as_uint(m), 4)); m += __uint_as_float(dpp_ror(__float_as_uint(m), 8)); return m; }
template <int NK>
__device__ __forceinline__ void extract16x4(unsigned (&k)[4][NK], unsigned (&mine)[4], int fr) {
#pragma unroll
    for (int r = 0; r < 4; ++r) {
        mine[r] = 0u;
#define CE_(i, j) { const unsigned hi_ = max(k[r][i], k[r][j]), lo_ = min(k[r][i], k[r][j]); k[r][i] = hi_; k[r][j] = lo_; }
        if (NK == 8) { CE_(0,1) CE_(2,3) CE_(4,5) CE_(6,7) CE_(0,2) CE_(1,3) CE_(4,6) CE_(5,7) CE_(1,2) CE_(5,6) CE_(0,4) CE_(1,5) CE_(2,6) CE_(3,7) CE_(2,4) CE_(3,5) CE_(1,2) CE_(3,4) CE_(5,6) }
        else { CE_(0,1) CE_(2,3) CE_(0,2) CE_(1,3) CE_(1,2) }
#undef CE_
    }
#pragma unroll 1
    for (int it = 0; it < 16; ++it) {
        unsigned m[4];
#pragma unroll
        for (int r = 0; r < 4; ++r) m[r] = k[r][0];
#pragma unroll
        for (int r = 0; r < 4; ++r) m[r] = max(m[r], dpp_ror(m[r], 1));
#pragma unroll
        for (int r = 0; r < 4; ++r) m[r] = max(m[r], dpp_ror(m[r], 2));
#pragma unroll
        for (int r = 0; r < 4; ++r) m[r] = max(m[r], dpp_ror(m[r], 4));
#pragma unroll
        for (int r = 0; r < 4; ++r) m[r] = max(m[r], dpp_ror(m[r], 8));
#pragma unroll
        for (int r = 0; r < 4; ++r) {
            const bool win = (k[r][0] == m[r]);
#pragma unroll
            for (int q = 0; q + 1 < NK; ++q) k[r][q] = win ? k[r][q + 1] : k[r][q];
            k[r][NK - 1] = win ? 0u : k[r][NK - 1];
            mine[r] = (fr == it) ? m[r] : mine[r]; }
    }
}
static __device__ const unsigned char CAND_TAB[64] = {0, 1, 2, 3, 4, 5, 6, 7, 8, 9, 10, 11, 12, 13, 14, 15, 16, 17, 18, 19, 20, 21, 22, 23, 32, 33, 34, 35, 36, 48, 49, 50, 51, 64, 65, 66, 80, 81, 96, 97, 112, 113, 128, 144, 160, 176, 192, 208, 224, 240, 255, 255, 255, 255, 255, 255, 255, 255, 255, 255, 255, 255, 255, 255};
__device__ __forceinline__ void topk_tile(const bf16_t* Q0, const bf16_t* Q1, const bf16_t* SK, int* EIDX, float* EW, int t0, int h, int lane, const int (&cflat)[4]) {
    const int fr = lane & 15, fq = lane >> 4, rowb = lane & 48;
    const bf16_t* qb = (h < 4 ? Q0 : Q1) + (size_t)(t0 + fr) * 1024 + (h & 3) * 256 + 8 * fq;
    const bf16_t* skb = SK + (size_t)h * 32768 + fr * 128 + 8 * fq;
    unsigned m1a[4], m2a[4];
#pragma unroll
    for (int p = 0; p < 2; ++p) {
        f32x4 sc[8];
        bf16x8 a[4];
#pragma unroll
        for (int ks = 0; ks < 4; ++ks) a[ks] = *(const bf16x8*)(qb + p * 128 + 32 * ks);
#pragma unroll
        for (int nb = 0; nb < 8; ++nb) { f32x4 acc = {0.f, 0.f, 0.f, 0.f};
#pragma unroll
            for (int ks = 0; ks < 4; ++ks) { const bf16x8 bb = *(const bf16x8*)(skb + (size_t)(p * 128 + 16 * nb) * 128 + 32 * ks); acc = __builtin_amdgcn_mfma_f32_16x16x32_bf16(a[ks], bb, acc, 0, 0, 0); }
            sc[nb] = acc; __builtin_amdgcn_sched_barrier(0); }
        unsigned k1[4][8];
#pragma unroll
        for (int r = 0; r < 4; ++r)
#pragma unroll
            for (int nb = 0; nb < 8; ++nb) k1[r][nb] = (ordkey(sc[nb][r]) & ~127u) | (127u - (unsigned)(16 * nb + fr));
        if (p == 0) extract16x4<8>(k1, m1a, fr); else extract16x4<8>(k1, m2a, fr);
    }
    float s1[4], s2[4]; int i1[4], i2[4]; unsigned ck[4][4];
#pragma unroll
    for (int r = 0; r < 4; ++r) { s1[r] = keyval(m1a[r] & ~127u); s2[r] = keyval(m2a[r] & ~127u); i1[r] = 127 - (int)(m1a[r] & 127u); i2[r] = 127 - (int)(m2a[r] & 127u); }
#pragma unroll
    for (int r = 0; r < 4; ++r)
#pragma unroll
        for (int q = 0; q < 4; ++q) { const int fl = cflat[q]; const float a1 = __shfl(s1[r], rowb + ((fl >> 4) & 15)), a2 = __shfl(s2[r], rowb + (fl & 15));
            ck[r][q] = (fl != 255) ? ((ordkey(a1 + a2) & ~255u) | (255u - (unsigned)fl)) : 0u; }
    unsigned mk[4];
    extract16x4<4>(ck, mk, fr);
#pragma unroll
    for (int r = 0; r < 4; ++r) {
        const int flat = 255 - (int)(mk[r] & 255u), ci = flat >> 4, cj = flat & 15;
        const int e1 = __shfl(i1[r], rowb + ci), e2 = __shfl(i2[r], rowb + cj);
        const float sv = keyval(mk[r] & ~255u);
        const float mx = keyval(rowmax_u(mk[r]) & ~255u);
        const float ex = __expf(sv - mx);
        const float gsm = ex / rowsum_f(ex);
        const size_t o = (size_t)(t0 + 4 * fq + r) * 128 + h * 16 + fr;
        EIDX[o] = e1 * 128 + e2; EW[o] = gsm;
    }
}

__device__ __forceinline__ void topk_tile_lds(const bf16_t* Q0, const bf16_t* Q1, const LAS bf16_t* SKL, LAS unsigned short* IDXW, LAS unsigned short* GWW, int t0, int h, int lane, const int (&cflat)[4]) {
    const int fr = lane & 15, fq = lane >> 4, rowb = lane & 48;
    const bf16_t* qb = (h < 4 ? Q0 : Q1) + (size_t)(t0 + fr) * 1024 + (h & 3) * 256 + 8 * fq;
    const LAS bf16_t* skb = SKL + fr * 136 + 8 * fq;
    unsigned m1a[4], m2a[4];
#pragma unroll
    for (int p = 0; p < 2; ++p) {
        f32x4 sc[8];
        bf16x8 a[4];
#pragma unroll
        for (int ks = 0; ks < 4; ++ks) a[ks] = *(const bf16x8*)(qb + p * 128 + 32 * ks);
#pragma unroll
        for (int nb = 0; nb < 8; ++nb) { f32x4 acc = {0.f, 0.f, 0.f, 0.f};
#pragma unroll
            for (int ks = 0; ks < 4; ++ks) { const bf16x8 bb = *(const LAS bf16x8*)(skb + (p * 128 + 16 * nb) * 136 + 32 * ks); acc = __builtin_amdgcn_mfma_f32_16x16x32_bf16(a[ks], bb, acc, 0, 0, 0); }
            sc[nb] = acc; __builtin_amdgcn_sched_barrier(0); }
        unsigned k1[4][8];
#pragma unroll
        for (int r = 0; r < 4; ++r)
#pragma unroll
            for (int nb = 0; nb < 8; ++nb) k1[r][nb] = (ordkey(sc[nb][r]) & ~127u) | (127u - (unsigned)(16 * nb + fr));
        if (p == 0) extract16x4<8>(k1, m1a, fr); else extract16x4<8>(k1, m2a, fr);
    }
    float s1[4], s2[4]; int i1[4], i2[4]; unsigned ck[4][4];
#pragma unroll
    for (int r = 0; r < 4; ++r) { s1[r] = keyval(m1a[r] & ~127u); s2[r] = keyval(m2a[r] & ~127u); i1[r] = 127 - (int)(m1a[r] & 127u); i2[r] = 127 - (int)(m2a[r] & 127u); }
#pragma unroll
    for (int r = 0; r < 4; ++r)
#pragma unroll
        for (int q = 0; q < 4; ++q) { const int fl = cflat[q]; const float a1 = __shfl(s1[r], rowb + ((fl >> 4) & 15)), a2 = __shfl(s2[r], rowb + (fl & 15));
            ck[r][q] = (fl != 255) ? ((ordkey(a1 + a2) & ~255u) | (255u - (unsigned)fl)) : 0u; }
    unsigned mk[4];
    extract16x4<4>(ck, mk, fr);
#pragma unroll
    for (int r = 0; r < 4; ++r) {
        const int flat = 255 - (int)(mk[r] & 255u), ci = flat >> 4, cj = flat & 15;
        const int e1 = __shfl(i1[r], rowb + ci), e2 = __shfl(i2[r], rowb + cj);
        const float sv = keyval(mk[r] & ~255u);
        const float mx = keyval(rowmax_u(mk[r]) & ~255u);
        const float ex = __expf(sv - mx);
        const float gsm = ex / rowsum_f(ex);
        const int o = (4 * fq + r) * 128 + h * 16 + fr;
        IDXW[o] = (unsigned short)(e1 * 128 + e2); GWW[o] = __builtin_bit_cast(unsigned short, (_Float16)gsm);
    }
}


constexpr size_t BANDB = (size_t)16384 * 128;
template <bool SIGNED>
__device__ __forceinline__ void quant_rows(const float* tab, unsigned char* q8, float* scale, int gw, int NGW, int lane) {
#pragma unroll 2
    for (int r = gw; r < 16384; r += NGW) {
        const f32x4* src = (const f32x4*)(tab + (size_t)r * 1024 + 16 * lane);
        f32x4 v[4]; float mx = 0.f;
#pragma unroll
        for (int j = 0; j < 4; ++j) { v[j] = src[j]; mx = fmaxf(mx, fmaxf(fmaxf(fabsf(v[j].x), fabsf(v[j].y)), fmaxf(fabsf(v[j].z), fabsf(v[j].w)))); }
#pragma unroll
        for (int o = 1; o < 64; o <<= 1) mx = fmaxf(mx, __shfl_xor(mx, o));
        mx = fmaxf(mx, 1e-30f);
        const float inv = 127.0f / mx;
        u32x4 w;
#pragma unroll
        for (int j = 0; j < 4; ++j) {
            const int a = (int)rintf(v[j].x * inv), b = (int)rintf(v[j].y * inv), c = (int)rintf(v[j].z * inv), d = (int)rintf(v[j].w * inv);
            const int off = SIGNED ? 0 : 128;
            w[j] = (unsigned)((a + off) & 255) | ((unsigned)((b + off) & 255) << 8) | ((unsigned)((c + off) & 255) << 16) | ((unsigned)((d + off) & 255) << 24);
        }
        *(u32x4*)(q8 + (size_t)(lane >> 3) * BANDB + (size_t)r * 128 + 16 * (lane & 7)) = w;
        if (lane == 0) scale[r] = mx * (1.0f / 127.0f);
    }
}

__device__ __forceinline__ float gelu_tanh(float x) { const float y = 0.7978845608028654f * (x + 0.044715f * x * x * x); const float th = 1.0f - 2.0f * __builtin_amdgcn_rcpf(1.0f + __expf(2.0f * y)); return 0.5f * x * (1.0f + th); }
__device__ __forceinline__ float ub0(unsigned w) { return (float)(w & 0xffu); }
__device__ __forceinline__ float ub1(unsigned w) { return (float)((w >> 8) & 0xffu); }
__device__ __forceinline__ float ub2(unsigned w) { return (float)((w >> 16) & 0xffu); }
__device__ __forceinline__ float ub3(unsigned w) { return (float)(w >> 24); }
__device__ __forceinline__ void sort128(int& e0, int& e1, float& w0, float& w1, int lane) {
    unsigned k0 = ((unsigned)e0 << 7) | (unsigned)lane, k1 = ((unsigned)e1 << 7) | (unsigned)(64 + lane);
#pragma unroll
    for (int k = 2; k <= 128; k <<= 1) {
#pragma unroll
        for (int j = k >> 1; j >= 1; j >>= 1) {
            if (j == 64) { const unsigned lo = min(k0, k1), hi = max(k0, k1); k0 = lo; k1 = hi; }
            else {
                const unsigned o0 = (unsigned)__shfl_xor((int)k0, j), o1 = (unsigned)__shfl_xor((int)k1, j);
                const bool lower = (lane & j) == 0;
                const bool up0 = (lane & k) == 0, up1 = ((lane + 64) & k) == 0;
                k0 = (up0 == lower) ? min(k0, o0) : max(k0, o0);
                k1 = (up1 == lower) ? min(k1, o1) : max(k1, o1);
            }
        }
    }
    const int p0 = (int)(k0 & 127u), p1 = (int)(k1 & 127u);
    const float a0 = __shfl(w0, p0 & 63), b0 = __shfl(w1, p0 & 63), a1 = __shfl(w0, p1 & 63), b1 = __shfl(w1, p1 & 63);
    e0 = (int)(k0 >> 7); e1 = (int)(k1 >> 7); w0 = (p0 < 64) ? a0 : b0; w1 = (p1 < 64) ? a1 : b1;
}
__device__ __forceinline__ void p15_fused(const Params& P, const bf16_t* Q0, const bf16_t* Q1, const bf16_t* SK, const bf16_t* XN, int* EIDX, float* EW, const unsigned char* UQ, const float* US, const unsigned char* VQ, const float* VS, const bf16_t* HB, float* HO, int bid, int G, int lane, int wave) {
    const float* gfin = P.in[24];
    int cflat[4];
#pragma unroll
    for (int q = 0; q < 4; ++q) cflat[q] = CAND_TAB[q * 16 + (lane & 15)];
#define PG_LOAD(U, V, eiv, lb8) do { _Pragma("unroll") for (int j = 0; j < 8; ++j) { const int ix = __builtin_amdgcn_readlane(eiv, (lb8) + j); \
            U[j] = *(const u32x4*)(UQ + (size_t)ix * 1024 + 16 * lane); V[j] = *(const u32x4*)(VQ + (size_t)ix * 1024 + 16 * lane); } } while (0)
#define PG_COMP(U, V, eiv, ewv, lb8) do { int part[8]; \
            _Pragma("unroll") for (int j = 0; j < 8; ++j) { int p = __builtin_amdgcn_sdot4(xq[0], (int)U[j].x, 0, false); p = __builtin_amdgcn_sdot4(xq[1], (int)U[j].y, p, false); \
                p = __builtin_amdgcn_sdot4(xq[2], (int)U[j].z, p, false); p = __builtin_amdgcn_sdot4(xq[3], (int)U[j].w, p, false); part[j] = p; } \
            int p4[4], p2[2], p1; \
            { const bool up = (lane & 32) != 0; _Pragma("unroll") for (int j = 0; j < 4; ++j) { const int send = up ? part[j] : part[j + 4], keep = up ? part[j + 4] : part[j]; p4[j] = keep + __shfl_xor(send, 32); } } \
            { const bool up = (lane & 16) != 0; _Pragma("unroll") for (int j = 0; j < 2; ++j) { const int send = up ? p4[j] : p4[j + 2], keep = up ? p4[j + 2] : p4[j]; p2[j] = keep + __shfl_xor(send, 16); } } \
            { const bool up = (lane & 8) != 0; const int send = up ? p2[0] : p2[1], keep = up ? p2[1] : p2[0]; p1 = keep + __shfl_xor(send, 8); } \
            p1 += __shfl_xor(p1, 4); p1 += __shfl_xor(p1, 2); p1 += __shfl_xor(p1, 1); \
            const int myj = ((lane >> 5) & 1) * 4 + ((lane >> 4) & 1) * 2 + ((lane >> 3) & 1); \
            const int myidx = __shfl(eiv, (lb8) + myj); const float wj = __shfl(ewv, (lb8) + myj); \
            const float cact = gelu_tanh((float)p1 * xs * US[myidx]) * wj * VS[myidx]; \
            _Pragma("unroll") for (int j = 0; j < 8; ++j) { \
                const int src = ((j >> 2) & 1) * 32 + ((j >> 1) & 1) * 16 + (j & 1) * 8; \
                const float aj = __uint_as_float((unsigned)__builtin_amdgcn_readlane((int)__float_as_uint(cact), src)); \
                const u32x4 vw = V[j]; csum += aj; \
                acc[0] += aj * ub0(vw.x); acc[1] += aj * ub1(vw.x); acc[2] += aj * ub2(vw.x); acc[3] += aj * ub3(vw.x); \
                acc[4] += aj * ub0(vw.y); acc[5] += aj * ub1(vw.y); acc[6] += aj * ub2(vw.y); acc[7] += aj * ub3(vw.y); \
                acc[8] += aj * ub0(vw.z); acc[9] += aj * ub1(vw.z); acc[10] += aj * ub2(vw.z); acc[11] += aj * ub3(vw.z); \
                acc[12] += aj * ub0(vw.w); acc[13] += aj * ub1(vw.w); acc[14] += aj * ub2(vw.w); acc[15] += aj * ub3(vw.w); } } while (0)
#define PG_ENTRIES(t, e0, e1, w0, w1) do { e0 = EIDX[(size_t)(t) * 128 + lane]; e1 = EIDX[(size_t)(t) * 128 + 64 + lane]; w0 = EW[(size_t)(t) * 128 + lane]; w1 = EW[(size_t)(t) * 128 + 64 + lane]; sort128(e0, e1, w0, w1, lane); } while (0)
    for (int tb = bid; tb < 256; tb += G) {
        const int tbase = tb * 128;
#pragma unroll 1
        for (int step = 0; step < 9; ++step) {
            if (wave >= 4) {
                if (step < 8) {
#pragma unroll 1
                    for (int hh = 0; hh < 2; ++hh) topk_tile(Q0, Q1, SK, EIDX, EW, tbase + 16 * step, 2 * (wave - 4) + hh, lane, cflat); }
            } else if (step >= 1) {
                const int tfirst = tbase + 16 * (step - 1) + 4 * wave;
                u32x4 uA[8], vA[8], uB[8], vB[8];
                int e0, e1; float w0, w1;
                PG_ENTRIES(tfirst, e0, e1, w0, w1);
                PG_LOAD(uA, vA, e0, 0);
#pragma unroll 1
                for (int tt = 0; tt < 4; ++tt) {
                    const int t = tfirst + tt, tn = tt < 3 ? t + 1 : t;
                    int e0n, e1n; float w0n, w1n;
                    PG_ENTRIES(tn, e0n, e1n, w0n, w1n);
                    const u32x4 xa = *(const u32x4*)(XN + (size_t)t * 1024 + 16 * lane), xb = *(const u32x4*)(XN + (size_t)t * 1024 + 16 * lane + 8);
                    float xf[16];
                    xf[0] = bflo(xa.x); xf[1] = bfhi(xa.x); xf[2] = bflo(xa.y); xf[3] = bfhi(xa.y); xf[4] = bflo(xa.z); xf[5] = bfhi(xa.z); xf[6] = bflo(xa.w); xf[7] = bfhi(xa.w);
                    xf[8] = bflo(xb.x); xf[9] = bfhi(xb.x); xf[10] = bflo(xb.y); xf[11] = bfhi(xb.y); xf[12] = bflo(xb.z); xf[13] = bfhi(xb.z); xf[14] = bflo(xb.w); xf[15] = bfhi(xb.w);
                    float mx = 0.f;
#pragma unroll
                    for (int e = 0; e < 16; ++e) mx = fmaxf(mx, fabsf(xf[e]));
#pragma unroll
                    for (int o = 1; o < 64; o <<= 1) mx = fmaxf(mx, __shfl_xor(mx, o));
                    mx = fmaxf(mx, 1e-30f);
                    const float xinv = 127.0f / mx, xs = mx * (1.0f / 127.0f);
                    int xq[4];
#pragma unroll
                    for (int j = 0; j < 4; ++j) { const int a = (int)rintf(xf[4 * j] * xinv), b = (int)rintf(xf[4 * j + 1] * xinv), c = (int)rintf(xf[4 * j + 2] * xinv), d = (int)rintf(xf[4 * j + 3] * xinv);
                        xq[j] = (int)((unsigned)(a & 255) | ((unsigned)(b & 255) << 8) | ((unsigned)(c & 255) << 16) | ((unsigned)(d & 255) << 24)); }
                    float acc[16]; float csum = 0.f;
#pragma unroll
                    for (int e = 0; e < 16; ++e) acc[e] = 0.f;
#pragma unroll 1
                    for (int bb = 0; bb < 16; bb += 2) {
                        const bool lo = bb < 8;
                        const int ev = lo ? e0 : e1; const float wv = lo ? w0 : w1; const int lb8 = (bb & 7) * 8;
                        PG_LOAD(uB, vB, ev, lb8 + 8);
                        PG_COMP(uA, vA, ev, wv, lb8);
                        { const int e2 = (bb + 2 < 8) ? e0 : (bb + 2 < 16) ? e1 : e0n; const int l2 = ((bb + 2) & 7) * 8; PG_LOAD(uA, vA, e2, l2); }
                        PG_COMP(uB, vB, ev, wv, lb8 + 8);
                    }
                    float* hr = HO + (size_t)t * 1024 + 16 * lane;
                    const u32x4 ha = *(const u32x4*)(HB + (size_t)t * 1024 + 16 * lane), hb = *(const u32x4*)(HB + (size_t)t * 1024 + 16 * lane + 8);
                    const float corr = -128.0f * csum;
                    acc[0] += bflo(ha.x) + corr; acc[1] += bfhi(ha.x) + corr; acc[2] += bflo(ha.y) + corr; acc[3] += bfhi(ha.y) + corr; acc[4] += bflo(ha.z) + corr; acc[5] += bfhi(ha.z) + corr; acc[6] += bflo(ha.w) + corr; acc[7] += bfhi(ha.w) + corr;
                    acc[8] += bflo(hb.x) + corr; acc[9] += bfhi(hb.x) + corr; acc[10] += bflo(hb.y) + corr; acc[11] += bfhi(hb.y) + corr; acc[12] += bflo(hb.z) + corr; acc[13] += bfhi(hb.z) + corr; acc[14] += bflo(hb.w) + corr; acc[15] += bfhi(hb.w) + corr;
                    float ss = 0.f;
#pragma unroll
                    for (int e = 0; e < 16; ++e) ss += acc[e] * acc[e];
                    const float rs = rsqrtf(wave_sum(ss) * (1.0f / 1024.0f) + 1e-6f);
                    const f32x4 g0 = *(const f32x4*)(gfin + 16 * lane), g1 = *(const f32x4*)(gfin + 16 * lane + 4), g2 = *(const f32x4*)(gfin + 16 * lane + 8), g3 = *(const f32x4*)(gfin + 16 * lane + 12);
                    f32x4 o0, o1, o2, o3;
                    o0.x = acc[0] * rs * g0.x; o0.y = acc[1] * rs * g0.y; o0.z = acc[2] * rs * g0.z; o0.w = acc[3] * rs * g0.w;
                    o1.x = acc[4] * rs * g1.x; o1.y = acc[5] * rs * g1.y; o1.z = acc[6] * rs * g1.z; o1.w = acc[7] * rs * g1.w;
                    o2.x = acc[8] * rs * g2.x; o2.y = acc[9] * rs * g2.y; o2.z = acc[10] * rs * g2.z; o2.w = acc[11] * rs * g2.w;
                    o3.x = acc[12] * rs * g3.x; o3.y = acc[13] * rs * g3.y; o3.z = acc[14] * rs * g3.z; o3.w = acc[15] * rs * g3.w;
                    *(f32x4*)(hr) = o0; *(f32x4*)(hr + 4) = o1; *(f32x4*)(hr + 8) = o2; *(f32x4*)(hr + 12) = o3;
                    e0 = e0n; e1 = e1n; w0 = w0n; w1 = w1n;
                }
            }
            __syncthreads();
        }
    }
#undef PG_LOAD
#undef PG_COMP
#undef PG_ENTRIES
}

#define DPPI(v, ctrl) __builtin_amdgcn_update_dpp(0, (v), (ctrl), 0xF, 0xF, true)
typedef int i32x4 __attribute__((ext_vector_type(4)));
typedef int i32x2 __attribute__((ext_vector_type(2)));
__device__ __forceinline__ void p15_band(const Params& P, const bf16_t* Q0, const bf16_t* Q1, const bf16_t* SK, const unsigned char* XQ, const float* XS, const unsigned char* UQ, const float* US,
                                         const unsigned char* VQ, const float* VS, const bf16_t* HB, float* HO, int tmask, int abl, LAS unsigned char* lds, int bid, int G, int lane, int wave) {
    const float* gfin = P.in[24];
    int cflat[4];
#pragma unroll
    for (int q = 0; q < 4; ++q) cflat[q] = CAND_TAB[q * 16 + (lane & 15)];
    const int seg = lane >> 3, dc = lane & 7;
    const unsigned dc16 = 16u * (unsigned)dc;
    LAS unsigned short* IDXW = (LAS unsigned short*)(lds) + wave * 2048;
    LAS unsigned short* GWW = (LAS unsigned short*)(lds + 32768) + wave * 2048;
    LAS int* DOTW = (LAS int*)(lds + 65536 + wave * 8192);
    LAS signed char* COEFW = (LAS signed char*)DOTW;
    LAS int* VSCR = DOTW + 512;
    LAS float* CSW = (LAS float*)(lds + 131072 + wave * 64);
#define PB_IDX(tk, I0, I1) do { const LAS u32x4* ip_ = (const LAS u32x4*)(IDXW + (tk) * 128 + seg * 16); I0 = ip_[0]; I1 = ip_[1]; } while (0)
#define PB_E(I0, I1, j) ((((j) < 8 ? I0 : I1)[((j) >> 1) & 3] >> (((j) & 1) * 16)) & 0xffffu)
#define PB_ROWS(tabb, I0, I1, R) do { _Pragma("unroll") for (int j = 0; j < 16; ++j) { const unsigned e_ = PB_E(I0, I1, j); R[j] = *(const u32x4*)((tabb) + (e_ * 128u + dc16)); } } while (0)
#define PB_UCOMP(R, X, tk, first) do { int part[16]; \
        _Pragma("unroll") for (int j = 0; j < 16; ++j) { int p = __builtin_amdgcn_sdot4((int)X.x, (int)R[j].x, 0, false); p = __builtin_amdgcn_sdot4((int)X.y, (int)R[j].y, p, false); \
            p = __builtin_amdgcn_sdot4((int)X.z, (int)R[j].z, p, false); p = __builtin_amdgcn_sdot4((int)X.w, (int)R[j].w, p, false); part[j] = p; } \
        _Pragma("unroll") for (int j = 0; j < 16; ++j) part[j] += DPPI(part[j], 0xB1); \
        _Pragma("unroll") for (int j = 0; j < 16; ++j) part[j] += DPPI(part[j], 0x4E); \
        _Pragma("unroll") for (int j = 0; j < 16; ++j) part[j] += DPPI(part[j], 0x141); \
        int v0 = part[0], v1 = part[8]; \
        _Pragma("unroll") for (int k = 1; k < 8; ++k) { v0 = (dc == k) ? part[k] : v0; v1 = (dc == k) ? part[k + 8] : v1; } \
        LAS int* dp_ = DOTW + (tk) * 128 + seg * 16 + dc; \
        if (first) { dp_[0] = v0; dp_[8] = v1; } else { dp_[0] += v0; dp_[8] += v1; } } while (0)
#define PB_VCOMP(R, C, HW, tk, OX, OY) do { int acc[16]; \
        _Pragma("unroll") for (int e = 0; e < 16; ++e) acc[e] = 0; \
        _Pragma("unroll") for (int g4 = 0; g4 < 4; ++g4) { const int cg_ = (int)C[g4]; \
            _Pragma("unroll") for (int r = 0; r < 4; ++r) { \
                const unsigned a0 = R[4 * g4][r], a1 = R[4 * g4 + 1][r], a2 = R[4 * g4 + 2][r], a3 = R[4 * g4 + 3][r]; \
                const unsigned p01a = __builtin_amdgcn_perm(a1, a0, 0x05010400u), p01b = __builtin_amdgcn_perm(a1, a0, 0x07030602u); \
                const unsigned p23a = __builtin_amdgcn_perm(a3, a2, 0x05010400u), p23b = __builtin_amdgcn_perm(a3, a2, 0x07030602u); \
                acc[4 * r + 0] = __builtin_amdgcn_sdot4((int)__builtin_amdgcn_perm(p23a, p01a, 0x05040100u), cg_, acc[4 * r + 0], false); \
                acc[4 * r + 1] = __builtin_amdgcn_sdot4((int)__builtin_amdgcn_perm(p23a, p01a, 0x07060302u), cg_, acc[4 * r + 1], false); \
                acc[4 * r + 2] = __builtin_amdgcn_sdot4((int)__builtin_amdgcn_perm(p23b, p01b, 0x05040100u), cg_, acc[4 * r + 2], false); \
                acc[4 * r + 3] = __builtin_amdgcn_sdot4((int)__builtin_amdgcn_perm(p23b, p01b, 0x07060302u), cg_, acc[4 * r + 3], false); } } \
        LAS i32x4* sw_ = (LAS i32x4*)(VSCR + seg * 128 + dc * 16); \
        _Pragma("unroll") for (int r = 0; r < 4; ++r) { i32x4 w_; w_.x = acc[4 * r]; w_.y = acc[4 * r + 1]; w_.z = acc[4 * r + 2]; w_.w = acc[4 * r + 3]; sw_[r] = w_; } \
        int s0 = 0, s1 = 0; \
        _Pragma("unroll") for (int sg = 0; sg < 8; ++sg) { const i32x2 v_ = *(const LAS i32x2*)(VSCR + sg * 128 + 2 * lane); s0 += v_.x; s1 += v_.y; } \
        const float cs_ = CSW[tk]; \
        OX = (float)s0 * cs_ + bflo(HW); OY = (float)s1 * cs_ + bfhi(HW); } while (0)
    for (int tb = bid; tb < 256; tb += G) {
        const int t0 = tb * 128 + wave * 16;
        if (!(abl & 1)) {
            LAS bf16_t* SKL = (LAS bf16_t*)(lds + 65536);
#pragma unroll 1
            for (int h = 0; h < 8; ++h) {
                __syncthreads();
#pragma unroll
                for (int i = 0; i < 8; ++i) { const int p = (wave * 64 + lane) + 512 * i, row = p >> 4, ck = (p & 15) * 8;
                    *(LAS u32x4*)(SKL + row * 136 + ck) = *(const u32x4*)(SK + (size_t)h * 32768 + row * 128 + ck); }
                __syncthreads();
                topk_tile_lds(Q0, Q1, SKL, IDXW, GWW, t0, h, lane, cflat);
            }
            __syncthreads();
        }
        if (!(abl & 2)) {
            u32x4 rA[16], rB[16], xA, xB, iA0, iA1, iB0, iB1;
            const unsigned char* xb = XQ + (size_t)t0 * 1024 + dc16;
            PB_IDX(0, iA0, iA1); PB_ROWS(UQ, iA0, iA1, rA); xA = *(const u32x4*)(xb);
#pragma unroll 1
            for (int it = 0; it < 128; it += 2) {
                const int band = it >> 4, tk = it & 15;
                const unsigned char* ub = UQ + (size_t)band * BANDB;
                PB_IDX(tk + 1, iB0, iB1); PB_ROWS(ub, iB0, iB1, rB); xB = *(const u32x4*)(xb + (tk + 1) * 1024 + band * 128);
                __builtin_amdgcn_sched_barrier(0); PB_UCOMP(rA, xA, tk, it < 16); __builtin_amdgcn_sched_barrier(0);
                { const int it2 = it + 2 < 128 ? it + 2 : 127, band2 = it2 >> 4, tk2 = it2 & 15; const unsigned char* ub2 = UQ + (size_t)band2 * BANDB;
                  PB_IDX(tk2, iA0, iA1); PB_ROWS(ub2, iA0, iA1, rA); xA = *(const u32x4*)(xb + tk2 * 1024 + band2 * 128); }
                __builtin_amdgcn_sched_barrier(0); PB_UCOMP(rB, xB, tk + 1, it < 16); __builtin_amdgcn_sched_barrier(0);
            }
        }
        if (!(abl & 4))
#pragma unroll 2
        for (int tk = 0; tk < 16; ++tk) {
            const int e0 = IDXW[tk * 128 + lane], e1 = IDXW[tk * 128 + 64 + lane];
            const float g0 = (float)__builtin_bit_cast(_Float16, GWW[tk * 128 + lane]), g1 = (float)__builtin_bit_cast(_Float16, GWW[tk * 128 + 64 + lane]);
            const int d0 = DOTW[tk * 128 + lane], d1 = DOTW[tk * 128 + 64 + lane];
            const float xs = XS[t0 + tk];
            const float c0 = gelu_tanh((float)d0 * xs * US[e0]) * g0 * VS[e0], c1 = gelu_tanh((float)d1 * xs * US[e1]) * g1 * VS[e1];
            float mx = fmaxf(fabsf(c0), fabsf(c1));
#pragma unroll
            for (int o = 1; o < 64; o <<= 1) mx = fmaxf(mx, __shfl_xor(mx, o));
            mx = fmaxf(mx, 1e-30f);
            const float inv = 127.0f / mx;
            COEFW[tk * 128 + lane] = (signed char)(int)rintf(c0 * inv); COEFW[tk * 128 + 64 + lane] = (signed char)(int)rintf(c1 * inv);
            if (lane == 0) CSW[tk] = mx * (1.0f / 127.0f);
        }
        if (!(abl & 8)) {
            u32x4 rA[16], rB[16], cA, cB, iA0, iA1, iB0, iB1; unsigned hA, hB;
            bf16_t* hbw = (bf16_t*)HB + (size_t)t0 * 1024 + 2 * lane;
            const bf16_t* hb = hbw;
            PB_IDX(0, iA0, iA1); PB_ROWS(VQ, iA0, iA1, rA); cA = *(const LAS u32x4*)(COEFW + seg * 16); hA = *(const unsigned*)(hb);
#pragma unroll 1
            for (int it = 0; it < 112; it += 2) {
                const int band = it >> 4, tk = it & 15;
                const unsigned char* vb = VQ + (size_t)band * BANDB;
                PB_IDX(tk + 1, iB0, iB1); PB_ROWS(vb, iB0, iB1, rB); cB = *(const LAS u32x4*)(COEFW + (tk + 1) * 128 + seg * 16); hB = *(const unsigned*)(hb + (tk + 1) * 1024 + band * 128);
                __builtin_amdgcn_sched_barrier(0); { float ox, oy; PB_VCOMP(rA, cA, hA, tk, ox, oy); *(unsigned*)(hbw + tk * 1024 + band * 128) = pk2(ox, oy); } __builtin_amdgcn_sched_barrier(0);
                { const int it2 = it + 2, band2 = it2 >> 4, tk2 = it2 & 15; const unsigned char* vb2 = VQ + (size_t)band2 * BANDB;
                  PB_IDX(tk2, iA0, iA1); PB_ROWS(vb2, iA0, iA1, rA); cA = *(const LAS u32x4*)(COEFW + tk2 * 128 + seg * 16); hA = *(const unsigned*)(hb + tk2 * 1024 + band2 * 128); }
                __builtin_amdgcn_sched_barrier(0); { float ox, oy; PB_VCOMP(rB, cB, hB, tk + 1, ox, oy); *(unsigned*)(hbw + (tk + 1) * 1024 + band * 128) = pk2(ox, oy); } __builtin_amdgcn_sched_barrier(0);
            }
            unsigned pA[7], pB[7];
#define PB_PREV(tk, PV) do { _Pragma("unroll") for (int b_ = 0; b_ < 7; ++b_) PV[b_] = __hip_atomic_load((const unsigned*)(hb + (tk) * 1024 + b_ * 128), __ATOMIC_RELAXED, __HIP_MEMORY_SCOPE_AGENT); } while (0)
#define PB_FINAL(PV, OX, OY, tk) do { float vals[16]; \
                _Pragma("unroll") for (int b_ = 0; b_ < 7; ++b_) { vals[2 * b_] = bflo(PV[b_]); vals[2 * b_ + 1] = bfhi(PV[b_]); } vals[14] = OX; vals[15] = OY; \
                float ss_ = 0.f; _Pragma("unroll") for (int e = 0; e < 16; ++e) ss_ += vals[e] * vals[e]; \
                const float rs_ = rsqrtf(wave_sum(ss_) * (1.0f / 1024.0f) + 1e-6f); \
                float* hr_ = HO + (size_t)((t0 + (tk)) & tmask) * 1024 + 2 * lane; \
                _Pragma("unroll") for (int b_ = 0; b_ < 8; ++b_) { const cf2 g_ = *(const cf2*)(gfin + b_ * 128 + 2 * lane); cf2 o_; o_.x = vals[2 * b_] * rs_ * g_.x; o_.y = vals[2 * b_ + 1] * rs_ * g_.y; __builtin_nontemporal_store(o_, (cf2*)(hr_ + b_ * 128)); } } while (0)
            PB_PREV(0, pA);
            const unsigned char* vb7 = VQ + (size_t)7 * BANDB;
#pragma unroll 1
            for (int tk = 0; tk < 16; tk += 2) {
                PB_IDX(tk + 1, iB0, iB1); PB_ROWS(vb7, iB0, iB1, rB); cB = *(const LAS u32x4*)(COEFW + (tk + 1) * 128 + seg * 16); hB = *(const unsigned*)(hb + (tk + 1) * 1024 + 7 * 128); PB_PREV(tk + 1, pB);
                __builtin_amdgcn_sched_barrier(0); { float ox, oy; PB_VCOMP(rA, cA, hA, tk, ox, oy); PB_FINAL(pA, ox, oy, tk); } __builtin_amdgcn_sched_barrier(0);
                { const int tk2 = tk + 2 < 16 ? tk + 2 : 15;
                  PB_IDX(tk2, iA0, iA1); PB_ROWS(vb7, iA0, iA1, rA); cA = *(const LAS u32x4*)(COEFW + tk2 * 128 + seg * 16); hA = *(const unsigned*)(hb + tk2 * 1024 + 7 * 128); PB_PREV(tk2, pA); }
                __builtin_amdgcn_sched_barrier(0); { float ox, oy; PB_VCOMP(rB, cB, hB, tk + 1, ox, oy); PB_FINAL(pB, ox, oy, tk + 1); } __builtin_amdgcn_sched_barrier(0);
            }
#undef PB_PREV
#undef PB_FINAL
        }
    }
#undef PB_IDX
#undef PB_E
#undef PB_ROWS
#undef PB_UCOMP
#undef PB_VCOMP
}

#define XB_TMO      128
#define XB_XCNT(j)  (256  + 64 * (j))
#define XB_XSUB(j)  (1280 + 64 * (j))
#define XB_XGEN(j)  (2304 + 64 * (j))
#define XB_TOP      3328
#define XB_TOPGEN   3392
#define XCD_BAR_WORDS 3456
#define XB_SPIN_CAP (1u << 18)

__device__ __forceinline__ unsigned xb_ld(unsigned* p)              { return __hip_atomic_load(p, __ATOMIC_RELAXED, __HIP_MEMORY_SCOPE_AGENT); }
__device__ __forceinline__ unsigned xb_add(unsigned* p, unsigned v) { return __hip_atomic_fetch_add(p, v, __ATOMIC_RELAXED, __HIP_MEMORY_SCOPE_AGENT); }
__device__ __forceinline__ unsigned xb_xcc_id() { return (unsigned)__builtin_amdgcn_s_getreg((3 << 11) | 20) & 0xFu; }
#define XB_SPIN(cond, bar) do { unsigned _sp = 0; while (cond) { __builtin_amdgcn_s_sleep(1); \
    if ((++_sp & 255u) == 0u) { if (xb_ld(&(bar)[XB_TMO])) break; if (_sp > XB_SPIN_CAP) { atomicAdd(&(bar)[XB_TMO], 1u); break; } } } } while (0)

struct XcdBarrier {
    unsigned* bar; unsigned x;
    volatile LAS unsigned* st;
};

__device__ __forceinline__ XcdBarrier xcd_barrier_post(unsigned* bar, volatile LAS unsigned* st) {
    XcdBarrier b; b.bar = bar; b.x = xb_xcc_id(); b.st = st;
    if (threadIdx.x == 0) (void)xb_add(&bar[XB_XCNT(b.x)], 1u);
    return b;
}
__device__ __forceinline__ void xcd_barrier_complete(unsigned* bar, unsigned x, unsigned& nloc, unsigned& nx) {
    const unsigned G = gridDim.x * gridDim.y * gridDim.z;
    unsigned sum, cnt, mine, sp = 0u;
    for (;;) {
        sum = 0u; cnt = 0u; mine = 0u;
#pragma unroll
        for (unsigned j = 0; j < 16; ++j) { const unsigned c = xb_ld(&bar[XB_XCNT(j)]); sum += c; cnt += (c > 0u) ? 1u : 0u; mine = (j == x) ? c : mine; }
        if (sum == G) break;
        __builtin_amdgcn_s_sleep(1);
        if ((++sp & 255u) == 0u) { if (xb_ld(&bar[XB_TMO])) break; if (sp > XB_SPIN_CAP) { atomicAdd(&bar[XB_TMO], 1u); break; } }
    }
    nloc = mine > 0u ? mine : 1u; nx = cnt > 0u ? cnt : 1u;
}

__device__ __forceinline__ void xcd_barrier(const XcdBarrier& b) {
    asm volatile("s_waitcnt vmcnt(0)" ::: "memory");
    __syncthreads();
    if (threadIdx.x == 0) {
        unsigned* bar = b.bar;
        __builtin_amdgcn_s_waitcnt(0);
        unsigned nloc = b.st[0], nx = b.st[1];
        if (nloc == 0u) { xcd_barrier_complete(bar, b.x, nloc, nx); b.st[0] = nloc; b.st[1] = nx; }
        const unsigned old = xb_add(&bar[XB_XSUB(b.x)], 1u);
        const unsigned gen = old / nloc;
        if (old + 1u == (gen + 1u) * nloc) {
            __builtin_amdgcn_fence(__ATOMIC_RELEASE, "agent");
            asm volatile("s_waitcnt vmcnt(0)" ::: "memory");
            const unsigned og = xb_add(&bar[XB_TOP], 1u);
            const unsigned tg = og / nx;
            if (og + 1u == (tg + 1u) * nx) xb_add(&bar[XB_TOPGEN], 1u);
            else XB_SPIN(xb_ld(&bar[XB_TOPGEN]) == tg, bar);
            __builtin_amdgcn_fence(__ATOMIC_ACQUIRE, "agent");
            xb_add(&bar[XB_XGEN(b.x)], 1u);
            asm volatile("s_waitcnt vmcnt(0)" ::: "memory");
        } else {
            XB_SPIN(xb_ld(&bar[XB_XGEN(b.x)]) == gen, bar);
            __builtin_amdgcn_fence(__ATOMIC_ACQUIRE, "agent");
            asm volatile("s_waitcnt vmcnt(0)" ::: "memory");
        }
    }
    __syncthreads();
}


constexpr int NPHASES = 16;
__global__ void __launch_bounds__(NTHREADS, 2) fwd_megakernel(Params P) {
    extern __shared__ __attribute__((aligned(16))) unsigned char lds_raw[];
    LAS unsigned char* lds = (LAS unsigned char*)lds_raw;
    cg::grid_group grid = cg::this_grid();
    const int G = gridDim.x, NGW = G * 8;
    const int abl15 = P.ph_lo >= 100 ? P.ph_lo - 100 : 0;
    const int lo = P.ph_lo >= 100 ? 15 : P.ph_lo, hi = P.ph_lo >= 100 ? 16 : P.ph_hi;
    volatile LAS unsigned* xbst = (volatile LAS unsigned*)(lds + LDS_BYTES - 64);
    if (threadIdx.x < 2) xbst[threadIdx.x] = 0u;
    __syncthreads();
    XcdBarrier xbar = xcd_barrier_post((unsigned*)(P.ws + (size_t)P.bar_region * (XCD_BAR_WORDS * 4)), xbst);
    if (P.ph_hi > 1000) grid.sync();
#define WSP (P.ws)
#define OUTP (P.out)
#define R0 ((bf16_t*)(WSP + WS_R0))
#define R1 ((bf16_t*)(WSP + WS_R0 + WS_RS))
#define R2 ((bf16_t*)(WSP + WS_R0 + 2 * WS_RS))
#define R3 ((bf16_t*)(WSP + WS_R0 + 3 * WS_RS))
#define R4 ((bf16_t*)(WSP + WS_R0 + 4 * WS_RS))
#define R5 ((bf16_t*)(WSP + WS_R0 + 5 * WS_RS))
#define O0 ((bf16_t*)OUTP)
#define O1 ((bf16_t*)((unsigned char*)OUTP + WS_RS))
#define XN ((bf16_t*)(WSP + WS_XN))
#define WIN ((bf16_t*)(WSP + WS_WIN))
#define UQ8 ((unsigned char*)(WSP + WS_R0 + 2 * WS_RS))
#define VQ8 ((unsigned char*)(WSP + WS_R0 + 2 * WS_RS + 16 * MiB))
#define USC ((float*)(WSP + WS_R0 + 2 * WS_RS + 32 * MiB))
#define VSC ((float*)(WSP + WS_R0 + 2 * WS_RS + 33 * MiB))
#define EIDX ((int*)(WSP + WS_R0 + 4 * WS_RS))
#define XQ8 ((unsigned char*)(WSP + WS_R0 + 4 * WS_RS))
#define XSC ((float*)(WSP + WS_R0 + 4 * WS_RS + 32 * MiB))
#define EW ((float*)(WSP + WS_R0 + 4 * WS_RS + 16 * MiB))
#define PHASE_BEGIN(k) if (lo <= (k) && (k) < hi) { \
        const int tid = threadIdx.x, lane = tid & 63, wave = __builtin_amdgcn_readfirstlane(tid >> 6), bid = blockIdx.x, gw = bid * 8 + wave; (void)lane; (void)gw;
#define PHASE_END(k) if ((k) + 1 < hi) xcd_barrier(xbar); }
#define EPI_INIT pg8::EpiGen E; E.o0 = E.o1 = E.o2 = E.o3 = E.o4 = nullptr; E.actbits = 0; E.mulmask = 0; E.mul = nullptr; E.add = nullptr; E.resid = nullptr; E.outf = nullptr;
#define RUN_GEMM(Aptr, Bptr, Ncols) do { __syncthreads(); pg8::Gemm g{(Aptr), (Bptr), T_, (Ncols), 1024}; pg8::StaticOrder S; S.init(T_, (Ncols), G, bid); \
        pg8::gemm_phase<pg8::EpiGen, pg8::StaticOrder, true, true>(lds, g, S, E); } while (0)

    PHASE_BEGIN(0) p0_prep(P, WSP, lds, gw, NGW, lane, wave); PHASE_END(0)
    PHASE_BEGIN(1) p1_filt(P, (const float*)(WSP + WS_HID), (float*)R5, tid, bid);
        EPI_INIT E.o0 = R0; E.o1 = R1; E.o2 = R2; RUN_GEMM(XN, WIN + (size_t)4096 * 1024, 3072); PHASE_END(1)
    PHASE_BEGIN(2) p2_conv(P, R0, R1, R2, R3, R4, lds, gw, NGW, lane, wave); PHASE_END(2)
    PHASE_BEGIN(3) p3_fft((const float*)R5, R3, (cf2*)R0, lds, tid, bid); PHASE_END(3)
    PHASE_BEGIN(5) p4_yb(R3, R4, lds, gw, NGW, lane, wave);
        EPI_INIT E.o0 = R0; E.o1 = R1; E.o2 = R2; E.o3 = R5; E.actbits = 1; RUN_GEMM(XN, WIN, 4096); PHASE_END(5)
    PHASE_BEGIN(6) p6a_prep(P, R0, R1, R2, R3, (float*)(WSP + WS_FAC), lds, tid, bid); PHASE_END(6)
    PHASE_BEGIN(7) p6b_scan(R0, R1, R2, R3, R5, (const float*)(WSP + WS_FAC), O0, O1, lds, tid, lane, wave, bid); PHASE_END(7)
    PHASE_BEGIN(8) p7_aa(P, O0, O1, R0, gw, NGW, lane); PHASE_END(8)
    PHASE_BEGIN(9) EPI_INIT E.o0 = R0; E.o1 = R1; E.o2 = R2; E.actbits = 1 | (2 << 2) | (2 << 4); E.mul = R0; E.mulmask = 1; RUN_GEMM(XN, WIN + (size_t)7168 * 1024, 3072); PHASE_END(9)
    PHASE_BEGIN(10) EPI_INIT E.o0 = R3; E.mul = R1; E.mulmask = 1; RUN_GEMM(R0, (bf16_t*)(WSP + WS_WA), 1024); PHASE_END(10)
    PHASE_BEGIN(11) EPI_INIT E.o0 = R5; E.mul = R2; E.mulmask = 1; E.add = R3; RUN_GEMM(R4, (bf16_t*)(WSP + WS_WB), 1024); PHASE_END(11)
    PHASE_BEGIN(12) EPI_INIT E.resid = P.in[0]; E.o0 = R3; RUN_GEMM(R5, (bf16_t*)(WSP + WS_WO), 1024); PHASE_END(12)
    PHASE_BEGIN(13) _Pragma("unroll 2") for (int m = gw; m < T_; m += NGW) rms_rowbf_to_bf16_q(R3 + (size_t)m * D_, P.in[19], XN + (size_t)m * D_, XQ8 + (size_t)m * D_, XSC + m, lane);
        quant_rows<true>(P.in[22], UQ8, USC, gw, NGW, lane); quant_rows<true>(P.in[23], VQ8, VSC, gw, NGW, lane); PHASE_END(13)
    PHASE_BEGIN(14) EPI_INIT E.o0 = R0; E.o1 = R1; RUN_GEMM(XN, (bf16_t*)(WSP + WS_WQ), 2048); PHASE_END(14)
    PHASE_BEGIN(15) p15_band(P, R0, R1, (const bf16_t*)(WSP + WS_SK), XQ8, XSC, UQ8, USC, VQ8, VSC, R3, abl15 ? (float*)R5 : OUTP, abl15 ? 16383 : 0x7fffffff, abl15, lds, bid, G, lane, wave); PHASE_END(15)
}

extern "C" void kernel_launch(void* const* d_in, const int* in_sizes, int n_in, void* d_out, int out_size, void* d_ws, size_t ws_size, hipStream_t stream) {
    static int grid_blocks = 0;
    if (grid_blocks == 0) {
        int dev = 0, cus = 0, per_cu = 0;
        (void)hipGetDevice(&dev);
        (void)hipDeviceGetAttribute(&cus, hipDeviceAttributeMultiprocessorCount, dev);
        (void)hipFuncSetAttribute((const void*)fwd_megakernel, hipFuncAttributeMaxDynamicSharedMemorySize, LDS_BYTES);
        (void)hipOccupancyMaxActiveBlocksPerMultiprocessor(&per_cu, (const void*)fwd_megakernel, NTHREADS, LDS_BYTES);
        (void)hipGetLastError();
        if (n_in != 25 || out_size != T_ * D_ || ws_size < WS_END || per_cu < 1 || cus < 1) {
            fprintf(stderr, "kernel_launch: unexpected problem (n_in %d out %d ws %zu per_cu %d cus %d); nothing launched\n", n_in, out_size, ws_size, per_cu, cus); grid_blocks = -1; return; }
        grid_blocks = cus;
    }
    if (grid_blocks < 0) return;
    Params p{};
    for (int i = 0; i < 25; ++i) p.in[i] = (const float*)d_in[i];
    p.out = (float*)d_out; p.ws = (unsigned char*)d_ws;
#ifndef PROBE_SEQ
#define PROBE_SEQ {0, NPHASES}
#endif
    const int seq[] = PROBE_SEQ;
    (void)hipMemsetAsync(d_ws, 0, (sizeof(seq) / sizeof(int) / 2) * (size_t)(XCD_BAR_WORDS * 4), stream);
    for (unsigned i = 0; i + 1 < sizeof(seq) / sizeof(int); i += 2) {
        p.ph_lo = seq[i]; p.ph_hi = seq[i + 1]; p.bar_region = (int)(i / 2); p.pad = 0;
        void* args[] = {&p};
        hipError_t e = hipLaunchCooperativeKernel((void*)fwd_megakernel, dim3(grid_blocks), dim3(NTHREADS), args, LDS_BYTES, stream);
        if (e != hipSuccess) fprintf(stderr, "cooperative launch failed: %s (grid %d)\n", hipGetErrorString(e), grid_blocks);
    }
}
```

```cpp
#include <hip/hip_runtime.h>
#include <hip/hip_cooperative_groups.h>
#include <cstdio>
#include <cstdint>
namespace cg = cooperative_groups;
namespace pg8 {
#define PG8_LAS __attribute__((address_space(3)))
typedef unsigned short bf16_t;
typedef short bf16x8 __attribute__((ext_vector_type(8)));
typedef float f32x4 __attribute__((ext_vector_type(4)));
typedef unsigned u32x4 __attribute__((ext_vector_type(4)));
constexpr int BM = 256, BK = 64, HALF = 128, HTB = HALF * BK * 2  , STAGE_BYTES = 8 * HTB, NXCD = 8, WGM = 8;

__host__ __device__ __forceinline__ int lds_byte(int r, int c) { const int st = (r >> 4) * 2 + (c >> 5), rr = r & 15, cc = c & 31, ob = rr * 64 + cc * 2; return st * 1024 + (ob ^ (((ob >> 9) & 1) << 5)); }
__host__ __device__ __forceinline__ void stage_rc(int b, int& R, int& C) { const int st = b / 1024, sb = b % 1024, swz = sb ^ (((sb >> 9) & 1) << 5); R = (st >> 1) * 16 + swz / 64; C = (st & 1) * 32 + (swz % 64) / 2; }
__host__ __device__ __forceinline__ int perm32(int rho) { const int n = rho >> 4, i = rho & 15; return 8 * (i >> 2) + 4 * n + (i & 3); }

struct Unit { int pm, pn; };
struct Gemm { const bf16_t* A; const bf16_t* Bt; int M, N, K; };

struct StaticOrder {
    int nM, nN, nwg, G, c;
    __host__ __device__ void init(int M, int N, int G_, int c_) { nM = M / BM; nN = N / BM; nwg = nM * nN; G = G_; c = c_; }
    __host__ __device__ bool next(int i, Unit& u) const {
        const long L = (long)i * G + c; if (L >= nwg) return false;
        int wgid = (int)L; { const int q = nwg / NXCD, r = nwg % NXCD, xcd = wgid % NXCD, off = wgid / NXCD; wgid = (xcd < r ? xcd * (q + 1) : r * (q + 1) + (xcd - r) * q) + off; }
        const int nig = WGM * nN, gid = wgid / nig, fm = gid * WGM, gsz = (nM - fm) < WGM ? (nM - fm) : WGM;
        u.pm = fm + ((wgid % nig) % gsz); u.pn = (wgid % nig) / gsz; return true;
    }
    __device__ __forceinline__ void a_ready(const Unit&) const {}
    __device__ __forceinline__ void done(const Unit&) const {}
};

typedef float cvt_f32x2_t __attribute__((ext_vector_type(2))); typedef __bf16 cvt_bf16x2_t __attribute__((ext_vector_type(2)));
__device__ __forceinline__ unsigned cvt_pk_bf16(float lo, float hi) { cvt_f32x2_t v = {lo, hi}; cvt_bf16x2_t b = __builtin_convertvector(v, cvt_bf16x2_t); return __builtin_bit_cast(unsigned, b); }
__device__ __forceinline__ float bfl(unsigned w) { return __uint_as_float(w << 16); }
__device__ __forceinline__ float bfh(unsigned w) { return __uint_as_float(w & 0xffff0000u); }
__device__ __forceinline__ float sigmoidf_(float x) { return __builtin_amdgcn_rcpf(1.0f + __expf(-x)); }
__device__ __forceinline__ f32x4 sigmoid4_(f32x4 v) {
    const f32x4 t = v * (-1.4426950408889634f);
    f32x4 ex; ex[0] = __builtin_amdgcn_exp2f(t[0]); ex[1] = __builtin_amdgcn_exp2f(t[1]); ex[2] = __builtin_amdgcn_exp2f(t[2]); ex[3] = __builtin_amdgcn_exp2f(t[3]);
    const f32x4 d = ex + 1.0f;
    f32x4 r; r[0] = __builtin_amdgcn_rcpf(d[0]); r[1] = __builtin_amdgcn_rcpf(d[1]); r[2] = __builtin_amdgcn_rcpf(d[2]); r[3] = __builtin_amdgcn_rcpf(d[3]);
    return r;
}
struct EpiGen {
    static constexpr bool PERM = true, AFTER_DRAIN = false;
    bf16_t *o0, *o1, *o2, *o3, *o4;
    int actbits;
    int mulmask;
    const bf16_t* mul; const bf16_t* add;
    const float* resid; float* outf;
    const float* rowscale;
    const unsigned* waitword; unsigned need; volatile PG8_LAS unsigned* wflag;
    __device__ __forceinline__ void operator()(const f32x4 (&acc)[2][2][4][2], const Unit& u, int wr, int wc, int fr, int fq) const {
        if (waitword) { if (*wflag == 0u) {
            if (threadIdx.x == 0) { unsigned sp = 0u;
                while (__hip_atomic_load(waitword, __ATOMIC_RELAXED, __HIP_MEMORY_SCOPE_AGENT) < need) { __builtin_amdgcn_s_sleep(1); if (++sp > (1u << 22)) break; }
                __builtin_amdgcn_fence(__ATOMIC_ACQUIRE, "agent"); asm volatile("s_waitcnt vmcnt(0)" ::: "memory"); }
            __syncthreads();
            if (threadIdx.x == 0) *wflag = 1u; } }
        const int grp = u.pn >> 2;
        bf16_t* base = grp == 0 ? o0 : grp == 1 ? o1 : grp == 2 ? o2 : grp == 3 ? o3 : o4;
        const int act = (actbits >> (2 * grp)) & 3;
        const int row0 = u.pm * BM + wr * 64 + fr, col0 = (u.pn & 3) * BM + wc * 32 + 8 * fq;
        float rsv[2][4];
#pragma unroll
        for (int ai = 0; ai < 2; ++ai)
#pragma unroll
            for (int m = 0; m < 4; ++m) rsv[ai][m] = rowscale ? rowscale[row0 + ai * HALF + m * 16] : 1.0f;
#pragma unroll
        for (int ai = 0; ai < 2; ++ai)
#pragma unroll
            for (int m = 0; m < 4; ++m) {
                const size_t off = (size_t)(row0 + ai * HALF + m * 16) * 1024 + col0;
                const float rsc = rsv[ai][m];
#pragma unroll
                for (int bj = 0; bj < 2; ++bj) {
                    f32x4 v0 = acc[ai][bj][m][0], v1 = acc[ai][bj][m][1];
                    if (rowscale) { v0 = v0 * rsc; v1 = v1 * rsc; }
                    const size_t o = off + bj * HALF;
                    if (act == 1) {
#pragma unroll
                        for (int e = 0; e < 1; ++e) { v0 = v0 * sigmoid4_(v0); v1 = v1 * sigmoid4_(v1); }
                    } else if (act == 2) {
#pragma unroll
                        for (int e = 0; e < 1; ++e) { v0 = sigmoid4_(v0); v1 = sigmoid4_(v1); }
                    }
                    if (mul && ((mulmask >> grp) & 1)) { const u32x4 mv = *(const u32x4*)(mul + o);
                        v0[0] *= bfl(mv.x); v0[1] *= bfh(mv.x); v0[2] *= bfl(mv.y); v0[3] *= bfh(mv.y); v1[0] *= bfl(mv.z); v1[1] *= bfh(mv.z); v1[2] *= bfl(mv.w); v1[3] *= bfh(mv.w); }
                    if (add) { const u32x4 av = *(const u32x4*)(add + o);
                        v0[0] += bfl(av.x); v0[1] += bfh(av.x); v0[2] += bfl(av.y); v0[3] += bfh(av.y); v1[0] += bfl(av.z); v1[1] += bfh(av.z); v1[2] += bfl(av.w); v1[3] += bfh(av.w); }
                    if (resid && !outf) { const f32x4 r0 = *(const f32x4*)(resid + o), r1 = *(const f32x4*)(resid + o + 4); v0 = v0 + r0; v1 = v1 + r1; }
                    if (outf) {
                        const f32x4 r0 = *(const f32x4*)(resid + o), r1 = *(const f32x4*)(resid + o + 4);
                        *(f32x4*)(outf + o) = v0 + r0; *(f32x4*)(outf + o + 4) = v1 + r1;
                    } else {
                        u32x4 w; w.x = cvt_pk_bf16(v0[0], v0[1]); w.y = cvt_pk_bf16(v0[2], v0[3]); w.z = cvt_pk_bf16(v1[0], v1[1]); w.w = cvt_pk_bf16(v1[2], v1[3]);
                        *(u32x4*)(base + o) = w;
                    }
                }
            }
    }
};
template <class Epi, class Sched, bool ALIGN_EPI = false, bool SP2 = false>
__device__ __forceinline__ void gemm_phase(PG8_LAS unsigned char* lds, const Gemm g, const Sched& S, const Epi& E) {
    const int tid = threadIdx.x, wid = __builtin_amdgcn_readfirstlane(tid >> 6), lane = tid & 63, wr = wid >> 2, wc = wid & 3, fr = lane & 15, fq = lane >> 4;
    const int K = g.K, nt = K / BK;
    unsigned voffA[2], voffB[2];
#pragma unroll
    for (int i = 0; i < 2; ++i) { int R, C; stage_rc(tid * 16 + i * 8192, R, C); const int Rb = Epi::PERM ? ((R & ~31) + perm32(R & 31)) : R;
        voffA[i] = (unsigned)(R * K + C) * 2u; voffB[i] = (unsigned)(Rb * K + C) * 2u; }
    const size_t kstep = (size_t)(BK * 2);
    const size_t hstep = (size_t)HALF * K * 2;
    const size_t tstep = 2 * hstep;
    const unsigned ldsw = (unsigned)wid * 1024u;
    const int aoff = lds_byte(wr * 64 + fr, fq * 8), boff = lds_byte(wc * 32 + fr, fq * 8);
#define PG8_SA(b, h) (((b) * 2 + (h)) * HTB)
#define PG8_SB(b, h) ((4 + (b) * 2 + (h)) * HTB)
#define PG8_STAGE(bufoff, gbase, voff) do { _Pragma("unroll") for (int _i = 0; _i < 2; ++_i) \
        __builtin_amdgcn_global_load_lds((const unsigned*)((const char*)(gbase) + (voff)[_i]), (PG8_LAS unsigned*)(lds + (bufoff) + ldsw + _i * 8192), 16, 0, 0); } while (0)
#define PG8_LDA(dst, b, h) do { _Pragma("unroll") for (int m = 0; m < 4; ++m) _Pragma("unroll") for (int k = 0; k < 2; ++k) dst[m][k] = *(const PG8_LAS bf16x8*)(lds + PG8_SA(b, h) + aoff + m * 2048 + k * 1024); } while (0)
#define PG8_LDB(dst, b, h) do { _Pragma("unroll") for (int n = 0; n < 2; ++n) _Pragma("unroll") for (int k = 0; k < 2; ++k) dst[n][k] = *(const PG8_LAS bf16x8*)(lds + PG8_SB(b, h) + boff + n * 2048 + k * 1024); } while (0)
#define PG8_MMA(ai, bj, At, Bt) do { __builtin_amdgcn_s_setprio(1); _Pragma("unroll") for (int m = 0; m < 4; ++m) _Pragma("unroll") for (int n = 0; n < 2; ++n) _Pragma("unroll") for (int k = 0; k < 2; ++k) \
        acc[ai][bj][m][n] = __builtin_amdgcn_mfma_f32_16x16x32_bf16(Bt[n][k], At[m][k], acc[ai][bj][m][n], 0, 0, 0); __builtin_amdgcn_s_setprio(0); } while (0)
#define PG8_WAIT_V(n) asm volatile("s_waitcnt vmcnt(" #n ")" ::: "memory")
#define PG8_WAIT_L(n) asm volatile("s_waitcnt lgkmcnt(" #n ")" ::: "memory")
#define PG8_BAR __builtin_amdgcn_s_barrier()
#define PG8_SCHED __builtin_amdgcn_sched_barrier(0)
    Unit cur, nxt; int ui = 0;
    if (!S.next(0, cur)) return;
    f32x4 acc[2][2][4][2];
#pragma unroll
    for (int a = 0; a < 2; ++a)
#pragma unroll
        for (int b = 0; b < 2; ++b)
#pragma unroll
            for (int m = 0; m < 4; ++m)
#pragma unroll
                for (int n = 0; n < 2; ++n) acc[a][b][m][n] = (f32x4){0.f, 0.f, 0.f, 0.f};
    bf16x8 At[4][2], B0[2][2], B1[2][2];
    const char* cA = (const char*)g.A + (size_t)cur.pm * tstep; const char* cB = (const char*)g.Bt + (size_t)cur.pn * tstep;
    S.a_ready(cur);
    if constexpr (SP2) {
        PG8_STAGE(PG8_SB(0, 0), cB, voffB); PG8_STAGE(PG8_SB(0, 1), cB + hstep, voffB); PG8_STAGE(PG8_SA(0, 0), cA, voffA); PG8_STAGE(PG8_SA(0, 1), cA + hstep, voffA);
        if (wr == 1) PG8_BAR;
        PG8_WAIT_V(2); PG8_BAR;
        PG8_STAGE(PG8_SB(1, 0), cB + kstep, voffB); PG8_STAGE(PG8_SA(1, 0), cA + kstep, voffA); PG8_STAGE(PG8_SB(1, 1), cB + hstep + kstep, voffB);
        PG8_WAIT_V(6); PG8_BAR;
    } else {
        PG8_STAGE(PG8_SB(0, 0), cB, voffB); PG8_STAGE(PG8_SA(0, 0), cA, voffA); PG8_STAGE(PG8_SB(0, 1), cB + hstep, voffB); PG8_STAGE(PG8_SA(0, 1), cA + hstep, voffA);
        if (wr == 1) PG8_BAR;
        PG8_WAIT_V(4); PG8_BAR;
        PG8_STAGE(PG8_SB(1, 0), cB + kstep, voffB); PG8_STAGE(PG8_SA(1, 0), cA + kstep, voffA); PG8_STAGE(PG8_SB(1, 1), cB + hstep + kstep, voffB);
        PG8_WAIT_V(6); PG8_BAR;
    }
    for (;;) {
        const bool has_next = S.next(ui + 1, nxt);
        const char* nA = has_next ? (const char*)g.A + (size_t)nxt.pm * tstep : cA; const char* nB = has_next ? (const char*)g.Bt + (size_t)nxt.pn * tstep : cB;
        for (int t = 0; t < nt; t += 2) {
            const bool last = (t == nt - 2);
            const char* a1 = cA + (size_t)(t + 1) * kstep;
            const char* a2 = last ? nA : cA + (size_t)(t + 2) * kstep; const char* b2 = last ? nB : cB + (size_t)(t + 2) * kstep;
            const char* a3 = a2 + kstep; const char* b3 = b2 + kstep;
            if (last && has_next) S.a_ready(nxt);
            if constexpr (SP2) {
            PG8_LDB(B0, 0, 0); PG8_LDB(B1, 0, 1); PG8_SCHED; PG8_LDA(At, 0, 0); PG8_STAGE(PG8_SA(1, 1), a1 + hstep, voffA);
            PG8_WAIT_V(8); PG8_WAIT_L(0); PG8_BAR; PG8_MMA(0, 0, At, B0); PG8_MMA(0, 1, At, B1); PG8_BAR; PG8_SCHED;
            PG8_LDA(At, 0, 1); PG8_STAGE(PG8_SB(0, 0), b2, voffB); PG8_STAGE(PG8_SB(0, 1), b2 + hstep, voffB); PG8_STAGE(PG8_SA(0, 0), a2, voffA);
            PG8_WAIT_V(8); PG8_WAIT_L(0); PG8_BAR; PG8_MMA(1, 0, At, B0); PG8_MMA(1, 1, At, B1); PG8_BAR; PG8_SCHED;
            PG8_LDB(B0, 1, 0); PG8_LDB(B1, 1, 1); PG8_SCHED; PG8_LDA(At, 1, 0); PG8_STAGE(PG8_SA(0, 1), a2 + hstep, voffA);
            PG8_WAIT_V(8); PG8_WAIT_L(0); PG8_BAR; PG8_MMA(0, 0, At, B0); PG8_MMA(0, 1, At, B1); PG8_BAR; PG8_SCHED;
            PG8_LDA(At, 1, 1); PG8_STAGE(PG8_SB(1, 0), b3, voffB); PG8_STAGE(PG8_SB(1, 1), b3 + hstep, voffB); PG8_STAGE(PG8_SA(1, 0), a3, voffA);
            PG8_WAIT_V(8); PG8_WAIT_L(0); PG8_BAR; PG8_MMA(1, 0, At, B0); PG8_MMA(1, 1, At, B1); PG8_BAR; PG8_SCHED;
            } else {
            PG8_LDB(B0, 0, 0); PG8_SCHED; PG8_LDA(At, 0, 0); PG8_STAGE(PG8_SA(1, 1), a1 + hstep, voffA);
            PG8_WAIT_L(8); PG8_BAR; PG8_WAIT_L(0); PG8_MMA(0, 0, At, B0); PG8_BAR; PG8_SCHED;
            PG8_LDB(B1, 0, 1); PG8_STAGE(PG8_SB(0, 0), b2, voffB);
            PG8_BAR; PG8_WAIT_L(0); PG8_MMA(0, 1, At, B1); PG8_BAR;
            PG8_LDA(At, 0, 1); PG8_STAGE(PG8_SA(0, 0), a2, voffA);
            PG8_BAR; PG8_WAIT_L(0); PG8_MMA(1, 0, At, B0); PG8_BAR; PG8_SCHED;
            PG8_STAGE(PG8_SB(0, 1), b2 + hstep, voffB);
            PG8_WAIT_V(6); PG8_BAR; PG8_MMA(1, 1, At, B1); PG8_BAR;
            PG8_LDB(B0, 1, 0); PG8_SCHED; PG8_LDA(At, 1, 0); PG8_STAGE(PG8_SA(0, 1), a2 + hstep, voffA);
            PG8_WAIT_L(8); PG8_BAR; PG8_WAIT_L(0); PG8_MMA(0, 0, At, B0); PG8_BAR; PG8_SCHED;
            PG8_LDB(B1, 1, 1); PG8_STAGE(PG8_SB(1, 0), b3, voffB);
            PG8_BAR; PG8_WAIT_L(0); PG8_MMA(0, 1, At, B1); PG8_BAR;
            PG8_LDA(At, 1, 1); PG8_STAGE(PG8_SA(1, 0), a3, voffA);
            PG8_BAR; PG8_WAIT_L(0); PG8_MMA(1, 0, At, B0); PG8_BAR; PG8_SCHED;
            PG8_STAGE(PG8_SB(1, 1), b3 + hstep, voffB);
            PG8_WAIT_V(6); PG8_BAR; PG8_MMA(1, 1, At, B1); PG8_BAR;
            }
        }
        if constexpr (ALIGN_EPI) { if (wr == 0) PG8_BAR; }
        if constexpr (!Epi::AFTER_DRAIN) { E(acc, cur, wr, wc, fr, fq); S.done(cur); }
        if (!has_next) break;
#pragma unroll
        for (int a = 0; a < 2; ++a)
#pragma unroll
            for (int b = 0; b < 2; ++b)
#pragma unroll
                for (int m = 0; m < 4; ++m)
#pragma unroll
                    for (int n = 0; n < 2; ++n) acc[a][b][m][n] = (f32x4){0.f, 0.f, 0.f, 0.f};
        cur = nxt; cA = nA; cB = nB; ++ui;
        if constexpr (ALIGN_EPI) { if (wr == 1) PG8_BAR; }
    }
    PG8_WAIT_V(0);
    if constexpr (!ALIGN_EPI) { if (wr == 0) PG8_BAR; }
    PG8_BAR;
    if constexpr (Epi::AFTER_DRAIN) { E.fused(acc, cur, wr, wc, fr, fq, lds, wid, lane); S.done(cur); }
#undef PG8_SA
#undef PG8_SB
#undef PG8_STAGE
#undef PG8_LDA
#undef PG8_LDB
#undef PG8_MMA
#undef PG8_WAIT_V
#undef PG8_WAIT_L
#undef PG8_BAR
#undef PG8_SCHED
}
}
constexpr int T_ = 32768, D_ = 1024, L_ = 8192, NB_ = 4;
constexpr size_t MiB = 1u << 20;
constexpr size_t WS_WIN = 1 * MiB;
constexpr size_t WS_WA = 21 * MiB, WS_WB = 23 * MiB, WS_WO = 25 * MiB;
constexpr size_t WS_WQ = 27 * MiB;
constexpr size_t WS_SK = 31 * MiB;
constexpr size_t WS_HID = 32 * MiB;
constexpr size_t WS_FAC = 34 * MiB;
constexpr size_t WS_RSTD1 = 47 * MiB;
constexpr size_t WS_XN = 64 * MiB;
constexpr size_t WS_R0 = 128 * MiB, WS_RS = 64 * MiB;
constexpr size_t WS_END = 512 * MiB;
constexpr int LDS_BYTES = 147456;
constexpr int NTHREADS = 512;
#ifndef GSYNC_EVERY
#define GSYNC_EVERY 0
#endif

#define LAS __attribute__((address_space(3)))
typedef unsigned short bf16_t;
typedef float f32x4 __attribute__((ext_vector_type(4)));
typedef float f32x16 __attribute__((ext_vector_type(16)));
typedef unsigned u32x4 __attribute__((ext_vector_type(4)));
typedef unsigned u32x2 __attribute__((ext_vector_type(2)));
typedef short bf16x8 __attribute__((ext_vector_type(8)));
typedef short v4i16_t __attribute__((ext_vector_type(4)));

__device__ __forceinline__ float bf2f(bf16_t v) { return __uint_as_float((unsigned)v << 16); }
__device__ __forceinline__ float bflo(unsigned w) { return __uint_as_float(w << 16); }
__device__ __forceinline__ float bfhi(unsigned w) { return __uint_as_float(w & 0xffff0000u); }
__device__ __forceinline__ unsigned pk2(float lo, float hi) { return pg8::cvt_pk_bf16(lo, hi); }
__device__ __forceinline__ bf16_t f2bf(float f) { return (bf16_t)(pk2(f, 0.f) & 0xffffu); }
__device__ __forceinline__ float wave_sum(float v) {
#pragma unroll
    for (int o = 1; o < 64; o <<= 1) v += __shfl_xor(v, o);
    return v;
}
#define LDS_WAIT() asm volatile("s_waitcnt lgkmcnt(0)" ::: "memory")

struct Params { const float* in[25]; float* out; unsigned char* ws; int ph_lo, ph_hi, bar_region, pad; };

typedef float cf2 __attribute__((ext_vector_type(2)));
#define FFT_HD __device__ __forceinline__
#define FFT_LDS LAS
#define FFT_COSREV(x) __builtin_amdgcn_cosf(x)
#define FFT_SINREV(x) __builtin_amdgcn_sinf(x)
#ifndef FFT_HD
#define FFT_HD __device__ __forceinline__
#endif
FFT_HD constexpr float c32f(int m) {
    constexpr float t[32] = {1.000000000e+00f, 9.807852804e-01f, 9.238795325e-01f, 8.314696123e-01f, 7.071067812e-01f, 5.555702330e-01f, 3.826834324e-01f, 1.950903220e-01f, 0.f, -1.950903220e-01f, -3.826834324e-01f, -5.555702330e-01f, -7.071067812e-01f, -8.314696123e-01f, -9.238795325e-01f, -9.807852804e-01f, -1.000000000e+00f, -9.807852804e-01f, -9.238795325e-01f, -8.314696123e-01f, -7.071067812e-01f, -5.555702330e-01f, -3.826834324e-01f, -1.950903220e-01f, 0.f, 1.950903220e-01f, 3.826834324e-01f, 5.555702330e-01f, 7.071067812e-01f, 8.314696123e-01f, 9.238795325e-01f, 9.807852804e-01f};
    return t[m & 31];
}
FFT_HD constexpr unsigned long long tw32(int m) {
    return (unsigned long long)__builtin_bit_cast(unsigned, c32f(m)) | ((unsigned long long)__builtin_bit_cast(unsigned, c32f(m + 24)) << 32);
}
template <int SIGN> FFT_HD cf2 cmul_s(cf2 d, unsigned long long cs) {
    const float c = __builtin_bit_cast(float, (unsigned)(cs & 0xffffffffull)), s = __builtin_bit_cast(float, (unsigned)(cs >> 32));
    const cf2 dsw = __builtin_shufflevector(d, d, 1, 0);
    cf2 sv; if (SIGN < 0) { sv.x = s; sv.y = -s; } else { sv.x = -s; sv.y = s; }
    const cf2 t = dsw * sv;
    cf2 cc; cc.x = c; cc.y = c;
    return __builtin_elementwise_fma(d, cc, t);
}
template <int SIGN> FFT_HD cf2 cmul_v(cf2 d, cf2 cs) {
    const cf2 dsw = __builtin_shufflevector(d, d, 1, 0);
    cf2 sv; if (SIGN < 0) { sv.x = cs.y; sv.y = -cs.y; } else { sv.x = -cs.y; sv.y = cs.y; }
    const cf2 t = dsw * sv;
    const cf2 cc = __builtin_shufflevector(cs, cs, 0, 0);
    return __builtin_elementwise_fma(d, cc, t);
}
template <int SIGN> FFT_HD cf2 rot90(cf2 d) {
    cf2 r; if (SIGN < 0) { r.x = d.y; r.y = -d.x; } else { r.x = -d.y; r.y = d.x; } return r;
}
template <int NP, int SIGN>
FFT_HD void dft_pow2(cf2 (&x)[NP]) {
    constexpr int LOG = (NP == 32) ? 5 : 4;
#pragma unroll
    for (int st = 0; st < LOG; ++st) {
        const int half = NP >> (st + 1);
#pragma unroll
        for (int b = 0; b < NP; b += 2 * half) {
#pragma unroll
            for (int i = 0; i < half; ++i) {
                const int p = b + i, q = b + i + half;
                const cf2 u = x[p], v = x[q];
                x[p] = u + v;
                const cf2 d = u - v;
                const int m = i * (16 / half);
                if (m == 0) x[q] = d;
                else if (m == 8) x[q] = rot90<SIGN>(d);
                else x[q] = cmul_s<SIGN>(d, tw32(m));
            }
        }
    }
    cf2 t[NP];
#pragma unroll
    for (int i = 0; i < NP; ++i) {
        int r = 0;
#pragma unroll
        for (int bb = 0; bb < LOG; ++bb) r |= ((i >> bb) & 1) << (LOG - 1 - bb);
        t[r] = x[i];
    }
#pragma unroll
    for (int i = 0; i < NP; ++i) x[i] = t[i];
}
FFT_HD cf2 twid(int m) {
    const float a = (float)m * (1.0f / 16384.0f);
    cf2 w; w.x = FFT_COSREV(a); w.y = FFT_SINREV(a); return w;
}
FFT_HD int fftA(int i) { return i + (i >> 5); }

FFT_HD void fft_fwd_p1(cf2 (&x)[16], int r_, FFT_LDS cf2* lds, int salt) {
    const int r = r_ + salt;
    dft_pow2<16, -1>(x);
    lds[fftA(r)] = x[0];
    const cf2 w = twid(r); cf2 cur = w;
#pragma unroll
    for (int k1 = 1; k1 < 16; ++k1) { lds[fftA(k1 * 1024 + r)] = cmul_v<-1>(x[k1], cur); if (k1 < 15) cur = cmul_v<+1>(cur, w); }
}
FFT_HD void fft_fwd_p2(int tid_, FFT_LDS cf2* lds, int salt) {
    const int tid = tid_ + salt, k1 = tid >> 5, r2 = tid & 31;
    cf2 x[32];
#pragma unroll
    for (int j = 0; j < 32; ++j) x[j] = lds[fftA(k1 * 1024 + j * 32 + r2)];
    dft_pow2<32, -1>(x);
    lds[fftA(k1 * 1024 + r2)] = x[0];
    const cf2 w = twid(16 * r2); cf2 cur = w;
#pragma unroll
    for (int k2 = 1; k2 < 32; ++k2) { lds[fftA(k1 * 1024 + k2 * 32 + r2)] = cmul_v<-1>(x[k2], cur); if (k2 < 31) cur = cmul_v<+1>(cur, w); }
}
FFT_HD void fft_fwd_p3(int tid, FFT_LDS cf2* lds, cf2 (&x)[32]) {
    const int base = fftA((tid >> 5) * 1024 + (tid & 31) * 32);
#pragma unroll
    for (int j = 0; j < 32; ++j) x[j] = lds[base + j];
    dft_pow2<32, -1>(x);
}
FFT_HD void fft_inv_p3(int tid_, FFT_LDS cf2* lds, cf2 (&x)[32], int salt) {
    const int tid = tid_ + salt, k2 = tid & 31, base = fftA((tid >> 5) * 1024 + k2 * 32);
    dft_pow2<32, +1>(x);
    lds[base] = x[0];
    const cf2 w = twid(16 * k2); cf2 cur = w;
#pragma unroll
    for (int r2 = 1; r2 < 32; ++r2) { lds[base + r2] = cmul_v<+1>(x[r2], cur); if (r2 < 31) cur = cmul_v<+1>(cur, w); }
}
FFT_HD void fft_inv_p2(int tid_, FFT_LDS cf2* lds, int salt) {
    const int tid = tid_ + salt, k1 = tid >> 5, r2 = tid & 31;
    cf2 x[32];
#pragma unroll
    for (int j = 0; j < 32; ++j) x[j] = lds[fftA(k1 * 1024 + j * 32 + r2)];
    dft_pow2<32, +1>(x);
    const cf2 w = twid(32 * k1); cf2 cur = twid(r2 * k1);
#pragma unroll
    for (int j2 = 0; j2 < 32; ++j2) { lds[fftA(k1 * 1024 + j2 * 32 + r2)] = cmul_v<+1>(x[j2], cur); if (j2 < 31) cur = cmul_v<+1>(cur, w); }
}
FFT_HD void fft_inv_p1(cf2 (&x)[16], int r, FFT_LDS cf2* lds) {
#pragma unroll
    for (int k1 = 0; k1 < 16; ++k1) x[k1] = lds[fftA(k1 * 1024 + r)];
    dft_pow2<16, +1>(x);
}


__device__ __forceinline__ void transpose_item(const float* W, int K, int N, bf16_t* WT, LAS float* scr, int item, int lane, bool perm_in = false, const float* kgain = nullptr) {
    const int nblk = N / 32, kb = item / nblk, nb = item % nblk, k0 = 64 * kb, n0 = 32 * nb;
    const int rshift = perm_in ? ((n0 >= 4096 && n0 < 5120) ? 3072 : (n0 >= 5120 && n0 < 8192) ? -1024 : 0) : 0;
#pragma unroll 8
    for (int i = 0; i < 32; ++i) { const int kk = 2 * i + (lane >> 5); scr[kk * 33 + (lane & 31)] = W[(size_t)(k0 + kk) * N + n0 + (lane & 31)]; }
    LDS_WAIT();
    const int c = lane & 7;
    f32x4 ga = {1.f, 1.f, 1.f, 1.f}, gb = ga;
    if (kgain) { ga = *(const f32x4*)(kgain + k0 + 8 * c); gb = *(const f32x4*)(kgain + k0 + 8 * c + 4); }
#pragma unroll
    for (int j = 0; j < 4; ++j) { const int n = (lane >> 3) + 8 * j; const LAS float* s = scr + (8 * c) * 33 + n;
        u32x4 o; o.x = pk2(s[0 * 33] * ga.x, s[1 * 33] * ga.y); o.y = pk2(s[2 * 33] * ga.z, s[3 * 33] * ga.w); o.z = pk2(s[4 * 33] * gb.x, s[5 * 33] * gb.y); o.w = pk2(s[6 * 33] * gb.z, s[7 * 33] * gb.w);
        *(u32x4*)(WT + (size_t)(n0 + n + rshift) * K + k0 + 8 * c) = o; }
    LDS_WAIT();
}
__device__ __forceinline__ void rms_row_to_bf16(const float* xrow, const float* g, bf16_t* orow, int lane) {
    const f32x4* xr = (const f32x4*)xrow + lane; f32x4 v[4]; float s = 0.f;
#pragma unroll
    for (int j = 0; j < 4; ++j) { v[j] = xr[64 * j]; s += (v[j].x * v[j].x + v[j].y * v[j].y) + (v[j].z * v[j].z + v[j].w * v[j].w); }
    const float rs = rsqrtf(wave_sum(s) * (1.0f / 1024.0f) + 1e-6f);
    u32x2* o8 = (u32x2*)orow + lane;
#pragma unroll
    for (int j = 0; j < 4; ++j) { const f32x4 gv = ((const f32x4*)g)[lane + 64 * j]; u32x2 w; w.x = pk2(v[j].x * rs * gv.x, v[j].y * rs * gv.y); w.y = pk2(v[j].z * rs * gv.z, v[j].w * rs * gv.w); o8[64 * j] = w; }
}
__device__ __forceinline__ void x_row_to_bf16_rstd(const float* xrow, bf16_t* orow, float* rstd, int lane) {
    const f32x4* xr = (const f32x4*)xrow + lane; f32x4 v[4]; float s = 0.f;
#pragma unroll
    for (int j = 0; j < 4; ++j) { v[j] = xr[64 * j]; s += (v[j].x * v[j].x + v[j].y * v[j].y) + (v[j].z * v[j].z + v[j].w * v[j].w); }
    const float rs = rsqrtf(wave_sum(s) * (1.0f / 1024.0f) + 1e-6f);
    u32x2* o8 = (u32x2*)orow + lane;
#pragma unroll
    for (int j = 0; j < 4; ++j) { u32x2 w; w.x = pk2(v[j].x, v[j].y); w.y = pk2(v[j].z, v[j].w); o8[64 * j] = w; }
    if (lane == 0) *rstd = rs;
}
__device__ __forceinline__ void rms_rowbf_to_bf16(const bf16_t* hrow, const float* g, bf16_t* orow, int lane) {
    const u32x4 a = *(const u32x4*)(hrow + 16 * lane), b = *(const u32x4*)(hrow + 16 * lane + 8);
    float v[16];
    v[0] = bflo(a.x); v[1] = bfhi(a.x); v[2] = bflo(a.y); v[3] = bfhi(a.y); v[4] = bflo(a.z); v[5] = bfhi(a.z); v[6] = bflo(a.w); v[7] = bfhi(a.w);
    v[8] = bflo(b.x); v[9] = bfhi(b.x); v[10] = bflo(b.y); v[11] = bfhi(b.y); v[12] = bflo(b.z); v[13] = bfhi(b.z); v[14] = bflo(b.w); v[15] = bfhi(b.w);
    float s = 0.f;
#pragma unroll
    for (int e = 0; e < 16; ++e) s += v[e] * v[e];
    const float rs = rsqrtf(wave_sum(s) * (1.0f / 1024.0f) + 1e-6f);
    const f32x4 g0 = *(const f32x4*)(g + 16 * lane), g1 = *(const f32x4*)(g + 16 * lane + 4), g2 = *(const f32x4*)(g + 16 * lane + 8), g3 = *(const f32x4*)(g + 16 * lane + 12);
    u32x4 w0, w1;
    w0.x = pk2(v[0] * rs * g0.x, v[1] * rs * g0.y); w0.y = pk2(v[2] * rs * g0.z, v[3] * rs * g0.w); w0.z = pk2(v[4] * rs * g1.x, v[5] * rs * g1.y); w0.w = pk2(v[6] * rs * g1.z, v[7] * rs * g1.w);
    w1.x = pk2(v[8] * rs * g2.x, v[9] * rs * g2.y); w1.y = pk2(v[10] * rs * g2.z, v[11] * rs * g2.w); w1.z = pk2(v[12] * rs * g3.x, v[13] * rs * g3.y); w1.w = pk2(v[14] * rs * g3.z, v[15] * rs * g3.w);
    *(u32x4*)(orow + 16 * lane) = w0; *(u32x4*)(orow + 16 * lane + 8) = w1;
}
__device__ __forceinline__ void rms_rowbf_q(const bf16_t* hrow, const float* g, unsigned char* xq, float* xs, float* rstd, int lane) {
    const u32x4 a = *(const u32x4*)(hrow + 16 * lane), b = *(const u32x4*)(hrow + 16 * lane + 8);
    float v[16];
    v[0] = bflo(a.x); v[1] = bfhi(a.x); v[2] = bflo(a.y); v[3] = bfhi(a.y); v[4] = bflo(a.z); v[5] = bfhi(a.z); v[6] = bflo(a.w); v[7] = bfhi(a.w);
    v[8] = bflo(b.x); v[9] = bfhi(b.x); v[10] = bflo(b.y); v[11] = bfhi(b.y); v[12] = bflo(b.z); v[13] = bfhi(b.z); v[14] = bflo(b.w); v[15] = bfhi(b.w);
    float s = 0.f;
#pragma unroll
    for (int e = 0; e < 16; ++e) s += v[e] * v[e];
    const float rs = rsqrtf(wave_sum(s) * (1.0f / 1024.0f) + 1e-6f);
    const f32x4 g0 = *(const f32x4*)(g + 16 * lane), g1 = *(const f32x4*)(g + 16 * lane + 4), g2 = *(const f32x4*)(g + 16 * lane + 8), g3 = *(const f32x4*)(g + 16 * lane + 12);
    v[0] *= rs * g0.x; v[1] *= rs * g0.y; v[2] *= rs * g0.z; v[3] *= rs * g0.w; v[4] *= rs * g1.x; v[5] *= rs * g1.y; v[6] *= rs * g1.z; v[7] *= rs * g1.w;
    v[8] *= rs * g2.x; v[9] *= rs * g2.y; v[10] *= rs * g2.z; v[11] *= rs * g2.w; v[12] *= rs * g3.x; v[13] *= rs * g3.y; v[14] *= rs * g3.z; v[15] *= rs * g3.w;
    float mx = 0.f;
#pragma unroll
    for (int e = 0; e < 16; ++e) mx = fmaxf(mx, fabsf(v[e]));
#pragma unroll
    for (int o = 1; o < 64; o <<= 1) mx = fmaxf(mx, __shfl_xor(mx, o));
    mx = fmaxf(mx, 1e-30f);
    const float xinv = 127.0f / mx;
    u32x4 q;
#pragma unroll
    for (int j = 0; j < 4; ++j) { const int a_ = (int)rintf(v[4 * j] * xinv), b_ = (int)rintf(v[4 * j + 1] * xinv), c_ = (int)rintf(v[4 * j + 2] * xinv), d_ = (int)rintf(v[4 * j + 3] * xinv);
        q[j] = (unsigned)(a_ & 255) | ((unsigned)(b_ & 255) << 8) | ((unsigned)(c_ & 255) << 16) | ((unsigned)(d_ & 255) << 24); }
    *(u32x4*)(xq + 16 * lane) = q;
    if (lane == 0) { *xs = mx * (1.0f / 127.0f); *rstd = rs; }
}
__device__ __forceinline__ void convert_f32_bf16(const float* src, bf16_t* dst, size_t n4, size_t gtid, size_t gn) {
    for (size_t i = gtid; i < n4; i += gn) { const f32x4 v = ((const f32x4*)src)[i]; u32x2 w; w.x = pk2(v.x, v.y); w.y = pk2(v.z, v.w); ((u32x2*)dst)[i] = w; }
}

__device__ __forceinline__ void p0_prep(const Params& P, unsigned char* ws, LAS unsigned char* lds, int gw, int NGW, int lane, int wave, int part) {
    LAS float* scr = (LAS float*)(lds + wave * 16384);
    constexpr int I_IN = 16 * 320, I_SQ = 16 * 32, I_Q = 16 * 64, NIT = I_IN + 3 * I_SQ + I_Q;
    for (int it = (part == 0 ? gw : I_IN + gw); it < (part == 0 ? I_IN : NIT); it += NGW) {
        int r = it;
        if (r < I_IN) { transpose_item(P.in[2], 1024, 10240, (bf16_t*)(ws + WS_WIN), scr, r, lane, true, P.in[1]); continue; } r -= I_IN;
        if (r < I_SQ) { transpose_item(P.in[16], 1024, 1024, (bf16_t*)(ws + WS_WA), scr, r, lane); continue; } r -= I_SQ;
        if (r < I_SQ) { transpose_item(P.in[17], 1024, 1024, (bf16_t*)(ws + WS_WB), scr, r, lane); continue; } r -= I_SQ;
        if (r < I_SQ) { transpose_item(P.in[18], 1024, 1024, (bf16_t*)(ws + WS_WO), scr, r, lane); continue; } r -= I_SQ;
        transpose_item(P.in[20], 1024, 2048, (bf16_t*)(ws + WS_WQ), scr, r, lane, false, P.in[19]);
    }
    if (part == 1) { convert_f32_bf16(P.in[21], (bf16_t*)(ws + WS_SK), 262144 / 4, (size_t)gw * 64 + lane, (size_t)NGW * 64); return; }
    bf16_t* XN = (bf16_t*)(ws + WS_XN);
#pragma unroll 2
    for (int m = gw; m < T_; m += NGW) x_row_to_bf16_rstd(P.in[0] + (size_t)m * D_, XN + (size_t)m * D_, (float*)(ws + WS_RSTD1) + m, lane);
    float* HID = (float*)(ws + WS_HID);
    const float* w1 = P.in[7]; const float* b1 = P.in[8]; const float* f1 = P.in[9]; const float* w2 = P.in[10]; const float* b2 = P.in[11]; const float* f2 = P.in[12];
    for (int n = gw; n < L_; n += NGW) {
        const float pos = (float)n, t = pos / 8191.0f;
        float zv = 0.f;
        if (lane == 0) zv = t;
        else if (lane <= 32) { const int bi = (lane - 1) & 15; const float band = 1e-4f + (float)bi * ((15.0f - 1e-4f) / 15.0f);
            const float ang = ((float)(2.0 * 3.14159265358979323846 / 8192.0) * pos) * band;
            zv = lane <= 16 ? cosf(ang) : -sinf(ang); }
        float h = 0.f;
#pragma unroll 3
        for (int i = 0; i < 33; ++i) h += __shfl(zv, i) * w1[i * 64 + lane];
        h = sinf(f1[lane] * (h + b1[lane]));
        float h2 = 0.f;
#pragma unroll 8
        for (int i = 0; i < 64; ++i) h2 += __shfl(h, i) * w2[i * 64 + lane];
        h2 = sinf(f2[lane] * (h2 + b2[lane]));
        HID[n * 64 + lane] = h2;
    }
}

__device__ __forceinline__ f32x16 mfma32(bf16x8 a, bf16x8 b, f32x16 c) { return __builtin_amdgcn_mfma_f32_32x32x16_bf16(a, b, c, 0, 0, 0); }
__device__ __forceinline__ f32x4 mfma16(bf16x8 a, bf16x8 b, f32x4 c) { return __builtin_amdgcn_mfma_f32_16x16x32_bf16(a, b, c, 0, 0, 0); }
__device__ __forceinline__ bf16x8 pack8(const float (&f)[8]) { u32x4 w; w.x = pk2(f[0], f[1]); w.y = pk2(f[2], f[3]); w.z = pk2(f[4], f[5]); w.w = pk2(f[6], f[7]); return __builtin_bit_cast(bf16x8, w); }
__device__ __forceinline__ void p1_filt(const Params& P, const float* HID, float* FILT, int tid, int bid) {
    const float* w3 = P.in[13]; const float* decay = P.in[14]; const float* bias = P.in[15];
    const int lane = tid & 63, wave = tid >> 6, r32 = lane & 31, hh = lane >> 5;
    for (int item = bid; item < 256; item += gridDim.x) {
        const int nb = item >> 4, cb = item & 15;
        bf16x8 bw[4][4]; float dec[4], bs[4];
#pragma unroll
        for (int cblk = 0; cblk < 4; ++cblk) { const int c = cb * 128 + 32 * cblk + r32;
            dec[cblk] = fabsf(decay[c]); bs[cblk] = (c < 1024) ? bias[c] : 0.f;
#pragma unroll
            for (int ks = 0; ks < 4; ++ks) { float f[8];
#pragma unroll
                for (int jj = 0; jj < 8; ++jj) f[jj] = w3[(16 * ks + 8 * hh + jj) * 2048 + c];
                bw[cblk][ks] = pack8(f); } }
#pragma unroll 1
        for (int q = 0; q < 2; ++q) {
            const int n0 = nb * 512 + (wave * 2 + q) * 32;
            bf16x8 af[4];
#pragma unroll
            for (int ks = 0; ks < 4; ++ks) { const f32x4* hp = (const f32x4*)(HID + (size_t)(n0 + r32) * 64 + 16 * ks + 8 * hh); const f32x4 a = hp[0], b = hp[1];
                float f[8] = {a.x, a.y, a.z, a.w, b.x, b.y, b.z, b.w}; af[ks] = pack8(f); }
#pragma unroll
            for (int cblk = 0; cblk < 4; ++cblk) {
                f32x16 acc;
#pragma unroll
                for (int e = 0; e < 16; ++e) acc[e] = 0.f;
#pragma unroll
                for (int ks = 0; ks < 4; ++ks) acc = mfma32(af[ks], bw[cblk][ks], acc);
                const int c = cb * 128 + 32 * cblk + r32;
#pragma unroll
                for (int g = 0; g < 4; ++g) {
                    const int nbase = n0 + 8 * g + 4 * hh;
                    float v[4];
#pragma unroll
                    for (int e = 0; e < 4; ++e) { const float t = (float)(nbase + e) / 8191.0f; v[e] = acc[4 * g + e] * __expf(-t * dec[cblk]); }
                    if (cb < 8) {
                        if (nbase == 0) v[0] += bs[cblk];
                        f32x4 o = {v[0], v[1], v[2], v[3]}; *(f32x4*)(FILT + (size_t)c * 16384 + nbase) = o;
                    } else {
                        float* row = FILT + (size_t)(c - 1024) * 16384;
                        if (nbase == 0) { row[16383] = v[1]; row[16382] = v[2]; row[16381] = v[3]; row[8192] = 0.f; }
                        else { f32x4 o = {v[3], v[2], v[1], v[0]}; *(f32x4*)(row + 16384 - nbase - 3) = o; }
                    }
                }
            }
        }
    }
}

__device__ __forceinline__ void unpack4(u32x2 w, float (&f)[4]) { f[0] = bflo(w.x); f[1] = bfhi(w.x); f[2] = bflo(w.y); f[3] = bfhi(w.y); }
__device__ __forceinline__ void p2_conv(const Params& P, const bf16_t* X0, const bf16_t* X1, const bf16_t* XV, bf16_t* UT, bf16_t* X0C, LAS unsigned char* lds, int gw, int NGW, int lane, int wave) {
    LAS bf16_t* tile = (LAS bf16_t*)(lds + wave * 9216);
    const float* cw = P.in[5]; const float* cb = P.in[6];
    const int cq = lane & 15, rg = lane >> 4;
    for (int tl = gw; tl < 8192; tl += NGW) {
        const int ct = tl & 15, tt = tl >> 4, b = tt >> 7, t0 = (tt & 127) * 64, c = ct * 64 + 4 * cq;
        const size_t rowb = (size_t)b * L_;
        u32x2 r0[18], r1[18], r2[18];
#pragma unroll
        for (int i = 0; i < 18; ++i) { const int t = t0 + 16 * rg + i - 1; const bool ok = (t >= 0) && (t < L_); const size_t o = (rowb + (ok ? t : 0)) * 1024 + c;
            const u32x2 z = {0u, 0u};
            r0[i] = ok ? *(const u32x2*)(X0 + o) : z; r1[i] = ok ? *(const u32x2*)(X1 + o) : z; r2[i] = ok ? *(const u32x2*)(XV + o) : z; }
        f32x4 w0[3], w1[3], w2[3];
#pragma unroll
        for (int jj = 0; jj < 3; ++jj) { w0[jj] = *(const f32x4*)(cw + jj * 3072 + c); w1[jj] = *(const f32x4*)(cw + jj * 3072 + 1024 + c); w2[jj] = *(const f32x4*)(cw + jj * 3072 + 2048 + c); }
        const f32x4 bb0 = *(const f32x4*)(cb + c), bb1 = *(const f32x4*)(cb + 1024 + c), bb2 = *(const f32x4*)(cb + 2048 + c);
        float uu[4][16];
#pragma unroll
        for (int i = 0; i < 16; ++i) {
            float a[4], bq[4], cc[4], x0o[4];
            float m0[4], m1[4], m2[4];
            unpack4(r0[i], a); unpack4(r0[i + 1], bq); unpack4(r0[i + 2], cc);
#pragma unroll
            for (int e = 0; e < 4; ++e) x0o[e] = bb0[e] + w0[0][e] * a[e] + w0[1][e] * bq[e] + w0[2][e] * cc[e];
            unpack4(r1[i], a); unpack4(r1[i + 1], bq); unpack4(r1[i + 2], cc);
#pragma unroll
            for (int e = 0; e < 4; ++e) m1[e] = bb1[e] + w1[0][e] * a[e] + w1[1][e] * bq[e] + w1[2][e] * cc[e];
            unpack4(r2[i], a); unpack4(r2[i + 1], bq); unpack4(r2[i + 2], cc);
#pragma unroll
            for (int e = 0; e < 4; ++e) { m2[e] = bb2[e] + w2[0][e] * a[e] + w2[1][e] * bq[e] + w2[2][e] * cc[e]; uu[e][i] = m2[e] * m1[e]; }
            (void)m0;
            u32x2 xo; xo.x = pk2(x0o[0], x0o[1]); xo.y = pk2(x0o[2], x0o[3]);
            *(u32x2*)(X0C + (rowb + t0 + 16 * rg + i) * 1024 + c) = xo;
        }
#pragma unroll
        for (int e = 0; e < 4; ++e) {
            u32x4 wa, wb;
            wa.x = pk2(uu[e][0], uu[e][1]); wa.y = pk2(uu[e][2], uu[e][3]); wa.z = pk2(uu[e][4], uu[e][5]); wa.w = pk2(uu[e][6], uu[e][7]);
            wb.x = pk2(uu[e][8], uu[e][9]); wb.y = pk2(uu[e][10], uu[e][11]); wb.z = pk2(uu[e][12], uu[e][13]); wb.w = pk2(uu[e][14], uu[e][15]);
            LAS u32x4* dst = (LAS u32x4*)(tile + (4 * cq + e) * 72 + 16 * rg); dst[0] = wa; dst[1] = wb;
        }
        LDS_WAIT();
#pragma unroll
        for (int cc = 0; cc < 16; ++cc) { const int cl = 4 * cc + rg;
            const u32x2 v = *(const LAS u32x2*)(tile + cl * 72 + 4 * cq);
            *(u32x2*)(UT + ((size_t)(ct * 64 + cl) * 4 + b) * L_ + t0 + 4 * cq) = v; }
        LDS_WAIT();
    }
}

__device__ __forceinline__ int fft_salt() { int z; asm volatile("v_mov_b32 %0, 0" : "=v"(z)); return z; }
__device__ __forceinline__ void p3_fft(const float* FILT, bf16_t* UT, cf2* KBUF, LAS unsigned char* lds, int tid, int bid) {
    LAS cf2* F = (LAS cf2*)lds;
    cf2* KB = KBUF + (size_t)bid * (32 * 512) + tid;
    for (int ch = bid; ch < 1024; ch += gridDim.x) {
        const float* kf = FILT + (size_t)ch * 16384;
#pragma unroll 1
        for (int h = 0; h < 2; ++h) { const int rr = tid + 512 * h; cf2 x[16];
#pragma unroll
            for (int j = 0; j < 16; ++j) { x[j].x = kf[1024 * j + rr]; x[j].y = 0.f; }
            fft_fwd_p1(x, rr, F, fft_salt()); }
        __syncthreads();
        fft_fwd_p2(tid, F, fft_salt());
        __syncthreads();
        { cf2 x[32];
          fft_fwd_p3(tid, F, x);
#pragma unroll
          for (int j = 0; j < 32; ++j) KB[j * 512] = x[j] * (1.0f / 16384.0f); }
        __syncthreads();
#pragma unroll 1
        for (int pr = 0; pr < 2; ++pr) {
            bf16_t* u0 = UT + ((size_t)ch * 4 + 2 * pr) * L_; bf16_t* u1 = u0 + L_;
#pragma unroll 1
            for (int h = 0; h < 2; ++h) { const int rr = tid + 512 * h; cf2 x[16];
#pragma unroll
                for (int j = 0; j < 8; ++j) { x[j].x = bf2f(u0[1024 * j + rr]); x[j].y = bf2f(u1[1024 * j + rr]); }
#pragma unroll
                for (int j = 8; j < 16; ++j) { x[j].x = 0.f; x[j].y = 0.f; }
                fft_fwd_p1(x, rr, F, fft_salt()); }
            __syncthreads();
            fft_fwd_p2(tid, F, fft_salt());
            __syncthreads();
            { cf2 x[32];
              fft_fwd_p3(tid, F, x);
#pragma unroll
              for (int j = 0; j < 32; ++j) x[j] = cmul_v<+1>(x[j], KB[j * 512]);
              fft_inv_p3(tid, F, x, fft_salt()); }
            __syncthreads();
            fft_inv_p2(tid, F, fft_salt());
            __syncthreads();
#pragma unroll 1
            for (int h = 0; h < 2; ++h) { const int rr = tid + 512 * h + fft_salt(); cf2 x[16];
                fft_inv_p1(x, rr, F);
#pragma unroll
                for (int j = 0; j < 8; ++j) { u0[1024 * j + rr] = f2bf(x[j].x); u1[1024 * j + rr] = f2bf(x[j].y); } }
        }
        __syncthreads();
    }
}

__device__ __forceinline__ void p4_yb(const bf16_t* UT, bf16_t* X0C, LAS unsigned char* lds, int gw, int NGW, int lane, int wave) {
    LAS bf16_t* tile = (LAS bf16_t*)(lds + wave * 9216);
    const int cq = lane & 15, rg = lane >> 4;
    for (int tl = gw; tl < 8192; tl += NGW) {
        const int ct = tl & 15, tt = tl >> 4, b = tt >> 7, t0 = (tt & 127) * 64;
#pragma unroll
        for (int cc = 0; cc < 16; ++cc) { const int cl = 4 * cc + rg;
            *(LAS u32x2*)(tile + cl * 72 + 4 * cq) = *(const u32x2*)(UT + ((size_t)(ct * 64 + cl) * 4 + b) * L_ + t0 + 4 * cq); }
        LDS_WAIT();
        u32x4 cv[4][2];
#pragma unroll
        for (int e = 0; e < 4; ++e) { const LAS u32x4* src = (const LAS u32x4*)(tile + (4 * cq + e) * 72 + 16 * rg); cv[e][0] = src[0]; cv[e][1] = src[1]; }
#pragma unroll
        for (int i = 0; i < 16; ++i) {
            const size_t o = ((size_t)b * L_ + t0 + 16 * rg + i) * 1024 + ct * 64 + 4 * cq;
            const u32x2 xv = *(const u32x2*)(X0C + o);
            float cf[4];
#pragma unroll
            for (int e = 0; e < 4; ++e) { const unsigned w = cv[e][i >> 3][(i >> 1) & 3]; cf[e] = (i & 1) ? bfhi(w) : bflo(w); }
            u32x2 yo; yo.x = pk2(bflo(xv.x) * cf[0], bfhi(xv.x) * cf[1]); yo.y = pk2(bflo(xv.y) * cf[2], bfhi(xv.y) * cf[3]);
            *(u32x2*)(X0C + o) = yo;
        }
        LDS_WAIT();
    }
}

__device__ __forceinline__ void p6a_prep(const Params& P, bf16_t* QF, bf16_t* KF, bf16_t* KB, bf16_t* QB, float* FACG, LAS unsigned char* lds, int tid, int bid) {
    LAS float* SEGF = (LAS float*)lds; LAS float* SEGB = SEGF + 1024;
    const float* lbl = P.in[3];
    const int k2 = (tid & 63) * 2, seg = tid >> 6;
    for (int unit = bid; unit < 4096; unit += gridDim.x) {
        const int c = unit & 127, h = (unit >> 7) & 7, b = unit >> 10;
        const float lbk0 = 1.0f / (1.0f + __expf(lbl[1024 + h * 128 + k2] - lbl[h * 128 + k2])), lbk1 = 1.0f / (1.0f + __expf(lbl[1024 + h * 128 + k2 + 1] - lbl[h * 128 + k2 + 1]));
        const float omlb0 = 1.0f - lbk0, omlb1 = 1.0f - lbk1;
        const size_t e0 = ((size_t)b * L_ + 64 * c + 8 * seg) * 1024 + h * 128 + k2;
        unsigned qv[8], zf[8], zb[8];
#pragma unroll
        for (int ii = 0; ii < 8; ++ii) { qv[ii] = *(const unsigned*)(QF + e0 + (size_t)ii * 1024); zf[ii] = *(const unsigned*)(KF + e0 + (size_t)ii * 1024); zb[ii] = *(const unsigned*)(KB + e0 + (size_t)ii * 1024); }
        float cf0[8], cf1[8], cb0[8], cb1[8], kf0[8], kf1[8], kb0[8], kb1[8];
        { float r0 = 1.f, r1 = 1.f;
#pragma unroll
          for (int ii = 0; ii < 8; ++ii) { const float f0 = lbk0 + omlb0 * __builtin_amdgcn_rcpf(1.0f + __expf(-bflo(zf[ii]))), f1 = lbk1 + omlb1 * __builtin_amdgcn_rcpf(1.0f + __expf(-bfhi(zf[ii])));
              r0 *= f0; r1 *= f1; cf0[ii] = r0; cf1[ii] = r1; kf0[ii] = 1.0f - f0; kf1[ii] = 1.0f - f1; }
          cf2 sv; sv.x = r0; sv.y = r1; *(LAS cf2*)(SEGF + seg * 128 + k2) = sv; }
        { float r0 = 1.f, r1 = 1.f;
#pragma unroll
          for (int ii = 7; ii >= 0; --ii) { const float f0 = lbk0 + omlb0 * __builtin_amdgcn_rcpf(1.0f + __expf(-bflo(zb[ii]))), f1 = lbk1 + omlb1 * __builtin_amdgcn_rcpf(1.0f + __expf(-bfhi(zb[ii])));
              r0 *= f0; r1 *= f1; cb0[ii] = r0; cb1[ii] = r1; kb0[ii] = 1.0f - f0; kb1[ii] = 1.0f - f1; }
          cf2 sv; sv.x = r0; sv.y = r1; *(LAS cf2*)(SEGB + seg * 128 + k2) = sv; }
        __syncthreads();
        float pf0 = 1.f, pf1 = 1.f, rf0 = 1.f, rf1 = 1.f, lf0 = 1.f, lf1 = 1.f, pb0 = 1.f, pb1 = 1.f, rb0 = 1.f, rb1 = 1.f, lb0 = 1.f, lb1 = 1.f;
#pragma unroll
        for (int s = 0; s < 8; ++s) { const cf2 a = *(const LAS cf2*)(SEGF + s * 128 + k2), bq = *(const LAS cf2*)(SEGB + s * 128 + k2);
            if (s < seg) { pf0 *= a.x; pf1 *= a.y; } if (s < 4) { rf0 *= a.x; rf1 *= a.y; } lf0 *= a.x; lf1 *= a.y;
            if (s > seg) { pb0 *= bq.x; pb1 *= bq.y; } if (s >= 4) { rb0 *= bq.x; rb1 *= bq.y; } lb0 *= bq.x; lb1 *= bq.y; }
        const float irf0 = __builtin_amdgcn_rcpf(rf0), irf1 = __builtin_amdgcn_rcpf(rf1), irb0 = __builtin_amdgcn_rcpf(rb0), irb1 = __builtin_amdgcn_rcpf(rb1);
        const float sf0 = pf0 * irf0, sf1 = pf1 * irf1, sb0 = pb0 * irb0, sb1 = pb1 * irb1;
#pragma unroll
        for (int ii = 0; ii < 8; ++ii) {
            const float q0 = bflo(qv[ii]), q1 = bfhi(qv[ii]);
            const float ef0 = sf0 * cf0[ii], ef1 = sf1 * cf1[ii], eb0 = sb0 * cb0[ii], eb1 = sb1 * cb1[ii];
            const size_t o = e0 + (size_t)ii * 1024;
            *(unsigned*)(QF + o) = pk2(q0 * ef0, q1 * ef1);
            *(unsigned*)(KF + o) = pk2(kf0[ii] * __builtin_amdgcn_rcpf(ef0), kf1[ii] * __builtin_amdgcn_rcpf(ef1));
            *(unsigned*)(QB + o) = pk2(q0 * eb0, q1 * eb1);
            *(unsigned*)(KB + o) = pk2(kb0[ii] * __builtin_amdgcn_rcpf(eb0), kb1[ii] * __builtin_amdgcn_rcpf(eb1));
        }
        if (seg == 0) {
            float* ff = FACG + ((size_t)((0 * 4 + b) * 8 + h) * 128 + c) * 384; float* fb = FACG + ((size_t)((1 * 4 + b) * 8 + h) * 128 + (127 - c)) * 384;
            cf2 w; w.x = rf0; w.y = rf1; *(cf2*)(ff + k2) = w; w.x = lf0; w.y = lf1; *(cf2*)(ff + 128 + k2) = w; w.x = lf0 * irf0; w.y = lf1 * irf1; *(cf2*)(ff + 256 + k2) = w;
            w.x = rb0; w.y = rb1; *(cf2*)(fb + k2) = w; w.x = lb0; w.y = lb1; *(cf2*)(fb + 128 + k2) = w; w.x = lb0 * irb0; w.y = lb1 * irb1; *(cf2*)(fb + 256 + k2) = w;
        }
        __syncthreads();
    }
}

__device__ __forceinline__ void p6b_scan(const bf16_t* QF, const bf16_t* KF, const bf16_t* KB, const bf16_t* QB, const bf16_t* VV, const float* FACG, bf16_t* OF, bf16_t* OB, LAS unsigned char* lds, int tid, int lane, int wid, int bid) {
    constexpr int SETB = 41472;
    LAS bf16_t* ST = (LAS bf16_t*)(lds + 2 * SETB);
    LAS bf16_t* PT = ST + 32 * 136;
    const int fr = lane & 15, fq = lane >> 4;
    LAS bf16_t* OT = PT + 64 * 72;
    const int r32 = lane & 31, hh = lane >> 5;
    for (int unit_ = bid; unit_ < 256; unit_ += gridDim.x) {
        const int unit = (gridDim.x == 256) ? ((((unit_ & 7) * 8 + (unit_ >> 5)) << 2) | ((unit_ >> 3) & 3)) : unit_;
        const int dir = unit >> 7, b = (unit >> 5) & 3, h = (unit >> 2) & 7, vs = unit & 3;
        const bf16_t* Qg = dir ? QB : QF; const bf16_t* Kg = dir ? KB : KF; bf16_t* O = dir ? OB : OF;
        const float* Fg = FACG + (size_t)((dir * 4 + b) * 8 + h) * 128 * 384;
        const size_t ubase = (size_t)b * L_ * 1024 + h * 128;
        const unsigned po0 = (unsigned)(((tid >> 4) * 1024 + (tid & 15) * 8) * 2), po1 = po0 + 32 * 1024 * 2;
        const unsigned pv = (unsigned)((((tid & 255) >> 2) * 1024 + (tid & 3) * 8) * 2);
        f32x4 S[2];
        S[0] = (f32x4){0.f, 0.f, 0.f, 0.f}; S[1] = S[0];
        u32x4 qA0, qA1, kA0, kA1, vA, fA, qB0, qB1, kB0, kB1, vB, fB, qC0, qC1, kC0, kC1, vC, fC, qD0, qD1, kD0, kD1, vD, fD;
#define HS_TROW(cc) (dir ? (127 - (cc)) * 64 : (cc) * 64)
#define HS_LOAD(cc, q0, q1, k0, k1, vv, ff) do { const int cc_ = (cc) < 128 ? (cc) : 127; \
            const size_t tb_ = ubase + (size_t)__builtin_amdgcn_readfirstlane(HS_TROW(cc_)) * 1024; \
            const char* qp_ = (const char*)(Qg + tb_); const char* kp_ = (const char*)(Kg + tb_); const char* vp_ = (const char*)(VV + tb_ + vs * 32); \
            q0 = *(const u32x4*)(qp_ + po0); q1 = *(const u32x4*)(qp_ + po1); k0 = *(const u32x4*)(kp_ + po0); k1 = *(const u32x4*)(kp_ + po1); \
            vv = *(const u32x4*)(vp_ + pv); ff = *(const u32x4*)(Fg + (size_t)cc_ * 384 + 4 * (tid < 96 ? tid : 0)); } while (0)
#define HS_STORE(sb, q0, q1, k0, k1, vv, ff) do { LAS bf16_t* QT_ = (LAS bf16_t*)(lds + (sb) * SETB); LAS bf16_t* KT_ = QT_ + 64 * 136; LAS bf16_t* VR_ = KT_ + 64 * 136; LAS float* FAC_ = (LAS float*)(VR_ + 64 * 40); \
            const int s0_ = tid >> 4, ck_ = (tid & 15) * 8; \
            *(LAS u32x4*)(QT_ + s0_ * 136 + ck_) = q0; *(LAS u32x4*)(QT_ + (s0_ + 32) * 136 + ck_) = q1; \
            *(LAS u32x4*)(KT_ + s0_ * 136 + ck_) = k0; *(LAS u32x4*)(KT_ + (s0_ + 32) * 136 + ck_) = k1; \
            if (tid < 256) *(LAS u32x4*)(VR_ + (tid >> 2) * 40 + (tid & 3) * 8) = vv; \
            if (tid < 96) *(LAS u32x4*)(FAC_ + 4 * tid) = ff; } while (0)
#define HS_TR8(img, stride, row0, col0) __builtin_shufflevector( \
            __builtin_amdgcn_ds_read_tr16_b64_v4i16((LAS v4i16_t*)((img) + ((row0) + (fr >> 2)) * (stride) + (col0) + 4 * (fr & 3))), \
            __builtin_amdgcn_ds_read_tr16_b64_v4i16((LAS v4i16_t*)((img) + ((row0) + 4 + (fr >> 2)) * (stride) + (col0) + 4 * (fr & 3))), 0, 1, 2, 3, 4, 5, 6, 7)
#define HS_FLUSH(cc, par) do { const u32x2 ov_ = *(const LAS u32x2*)(OT + (par) * 2048 + 4 * tid); \
            *(u32x2*)(O + ubase + ((size_t)__builtin_amdgcn_readfirstlane(HS_TROW(cc)) + (tid >> 3)) * 1024 + vs * 32 + 4 * (tid & 7)) = ov_; } while (0)
#define HS_ITER(c, X0, X1, X2, X3, X4, X5, Y0, Y1, Y2, Y3, Y4, Y5) do { \
            const int cur = (c) & 1; \
            LAS bf16_t* QT = (LAS bf16_t*)(lds + cur * SETB); LAS bf16_t* KT = QT + 64 * 136; LAS bf16_t* VR = KT + 64 * 136; LAS float* FAC = (LAS float*)(VR + 64 * 40); \
            HS_STORE(cur ^ 1, X0, X1, X2, X3, X4, X5); \
            HS_LOAD((c) + 5, X0, X1, X2, X3, X4, X5);     \
              \
            { const f32x4 fc = *(const LAS f32x4*)(FAC + 16 * wid + 4 * fq); \
              _Pragma("unroll") for (int vt = 0; vt < 2; ++vt) { u32x2 w; w.x = pk2(S[vt][0] * fc[0], S[vt][1] * fc[1]); w.y = pk2(S[vt][2] * fc[2], S[vt][3] * fc[3]); \
                  *(LAS u32x2*)(ST + (16 * vt + fr) * 136 + 16 * wid + 4 * fq) = w; } } \
            bf16x8 qa[4];        \
            { const int ti = wid >> 1; \
              _Pragma("unroll") for (int ks = 0; ks < 4; ++ks) qa[ks] = *(const LAS bf16x8*)(QT + (16 * ti + fr) * 136 + 32 * ks + 8 * fq); \
              _Pragma("unroll") for (int tq = 0; tq < 2; ++tq) { const int tj = 2 * (wid & 1) + tq; f32x4 acc = {0.f, 0.f, 0.f, 0.f}; \
                  if (dir ? (tj >= ti) : (tj <= ti)) {       \
                  _Pragma("unroll") for (int ks = 0; ks < 4; ++ks) { const bf16x8 bb = *(const LAS bf16x8*)(KT + (16 * tj + fr) * 136 + 32 * ks + 8 * fq); acc = mfma16(bb, qa[ks], acc); } }      \
                  { const int i = 16 * ti + fr, s0 = 16 * tj + 4 * fq; float mv[4]; \
                    _Pragma("unroll") for (int r = 0; r < 4; ++r) { const int s = s0 + r; const bool keep = dir ? (s >= i) : (s <= i); mv[r] = keep ? acc[r] : 0.f; } \
                    u32x2 w; w.x = pk2(mv[0], mv[1]); w.y = pk2(mv[2], mv[3]); *(LAS u32x2*)(PT + i * 72 + s0) = w; } } } \
            __syncthreads(); \
              \
            { const int it = wid >> 1, vt = wid & 1; f32x4 acc = {0.f, 0.f, 0.f, 0.f}; const unsigned vs1_ = vt ? 0xffffffffu : 0u; const u32x4 vsel = {vs1_, vs1_, vs1_, vs1_}; \
              bf16x8 vb[2][2]; \
              _Pragma("unroll") for (int k2 = 0; k2 < 2; ++k2) { vb[0][k2] = HS_TR8(VR, 40, 32 * k2 + 8 * fq, 0); vb[1][k2] = HS_TR8(VR, 40, 32 * k2 + 8 * fq, 16); } \
              _Pragma("unroll") for (int ks = 0; ks < 4; ++ks) { const bf16x8 bb = *(const LAS bf16x8*)(ST + (16 * vt + fr) * 136 + 32 * ks + 8 * fq); acc = mfma16(bb, qa[ks], acc); } \
              _Pragma("unroll") for (int k2 = 0; k2 < 2; ++k2) { const bf16x8 a = *(const LAS bf16x8*)(PT + (16 * it + fr) * 72 + 32 * k2 + 8 * fq); const bf16x8 bi = __builtin_bit_cast(bf16x8, (__builtin_bit_cast(u32x4, vb[1][k2]) & vsel) | (__builtin_bit_cast(u32x4, vb[0][k2]) & ~vsel)); acc = mfma16(bi, a, acc); }     \
              { u32x2 w; w.x = pk2(acc[0], acc[1]); w.y = pk2(acc[2], acc[3]); *(u32x2*)(O + ubase + ((size_t)__builtin_amdgcn_readfirstlane(HS_TROW(c)) + 16 * it + fr) * 1024 + vs * 32 + 16 * vt + 4 * fq) = w; }     \
              const f32x4 f1 = *(const LAS f32x4*)(FAC + 128 + 16 * wid + 4 * fq), f2 = *(const LAS f32x4*)(FAC + 256 + 16 * wid + 4 * fq); \
              bf16x8 ka[2]; \
              _Pragma("unroll") for (int k2 = 0; k2 < 2; ++k2) ka[k2] = HS_TR8(KT, 136, 32 * k2 + 8 * fq, 16 * wid); \
              _Pragma("unroll") for (int v2 = 0; v2 < 2; ++v2) { f32x4 d = {0.f, 0.f, 0.f, 0.f}; \
                  _Pragma("unroll") for (int k2 = 0; k2 < 2; ++k2) d = mfma16(ka[k2], vb[v2][k2], d); \
                  _Pragma("unroll") for (int r = 0; r < 4; ++r) S[v2][r] = f1[r] * S[v2][r] + f2[r] * d[r]; } } \
            __syncthreads(); } while (0)
        { u32x2 z_ = {0u, 0u}; *(LAS u32x2*)(OT + 2048 + 4 * tid) = z_; }
        HS_LOAD(0, qD0, qD1, kD0, kD1, vD, fD);
        HS_LOAD(1, qA0, qA1, kA0, kA1, vA, fA);
        HS_LOAD(2, qB0, qB1, kB0, kB1, vB, fB);
        HS_LOAD(3, qC0, qC1, kC0, kC1, vC, fC);
        HS_STORE(0, qD0, qD1, kD0, kD1, vD, fD);
        HS_LOAD(4, qD0, qD1, kD0, kD1, vD, fD);
        __syncthreads();
#pragma unroll 1
        for (int c = 0; c < 128; c += 4) {
            HS_ITER(c, qA0, qA1, kA0, kA1, vA, fA, qB0, qB1, kB0, kB1, vB, fB);
            HS_ITER(c + 1, qB0, qB1, kB0, kB1, vB, fB, qA0, qA1, kA0, kA1, vA, fA);
            HS_ITER(c + 2, qC0, qC1, kC0, kC1, vC, fC, qA0, qA1, kA0, kA1, vA, fA);
            HS_ITER(c + 3, qD0, qD1, kD0, kD1, vD, fD, qA0, qA1, kA0, kA1, vA, fA);
        }
        __syncthreads();
#undef HS_ITER
#undef HS_TR8
#undef HS_FLUSH
#undef HS_STORE
#undef HS_LOAD
#undef HS_TROW
    }
}

__device__ __forceinline__ void p7_aa(const Params& P, const bf16_t* OF, const bf16_t* OB, bf16_t* AA, int gw, int NGW, int lane) {
    const float* g = P.in[4];
#pragma unroll 2
    for (int m = gw; m < T_; m += NGW) {
        const size_t o = (size_t)m * 1024 + 16 * lane;
        const u32x4 f0 = *(const u32x4*)(OF + o), f1 = *(const u32x4*)(OF + o + 8), b0 = *(const u32x4*)(OB + o), b1 = *(const u32x4*)(OB + o + 8);
        float v[16];
        v[0] = bflo(f0.x) + bflo(b0.x); v[1] = bfhi(f0.x) + bfhi(b0.x); v[2] = bflo(f0.y) + bflo(b0.y); v[3] = bfhi(f0.y) + bfhi(b0.y);
        v[4] = bflo(f0.z) + bflo(b0.z); v[5] = bfhi(f0.z) + bfhi(b0.z); v[6] = bflo(f0.w) + bflo(b0.w); v[7] = bfhi(f0.w) + bfhi(b0.w);
        v[8] = bflo(f1.x) + bflo(b1.x); v[9] = bfhi(f1.x) + bfhi(b1.x); v[10] = bflo(f1.y) + bflo(b1.y); v[11] = bfhi(f1.y) + bfhi(b1.y);
        v[12] = bflo(f1.z) + bflo(b1.z); v[13] = bfhi(f1.z) + bfhi(b1.z); v[14] = bflo(f1.w) + bflo(b1.w); v[15] = bfhi(f1.w) + bfhi(b1.w);
        float ss = 0.f;
#pragma unroll
        for (int e = 0; e < 16; ++e) ss += v[e] * v[e];
        ss += __shfl_xor(ss, 1); ss += __shfl_xor(ss, 2); ss += __shfl_xor(ss, 4);
        const float rs = rsqrtf(ss * (1.0f / 128.0f) + 1e-6f);
        const float* gp = g + ((16 * lane) & 127);
#pragma unroll
        for (int e = 0; e < 16; ++e) v[e] = v[e] * rs * gp[e];
        u32x4 w0, w1; w0.x = pk2(v[0], v[1]); w0.y = pk2(v[2], v[3]); w0.z = pk2(v[4], v[5]); w0.w = pk2(v[6], v[7]); w1.x = pk2(v[8], v[9]); w1.y = pk2(v[10], v[11]); w1.z = pk2(v[12], v[13]); w1.w = pk2(v[14], v[15]);
        *(u32x4*)(AA + o) = w0; *(u32x4*)(AA + o + 8) = w1;
    }
}

__device__ __forceinline__ unsigned ordkey(float x) { const unsigned u = __float_as_uint(x); return u ^ ((u >> 31) ? 0xFFFFFFFFu : 0x80000000u); }
__device__ __forceinline__ float keyval(unsigned k) { return __uint_as_float(k ^ ((k >> 31) ? 0x80000000u : 0xFFFFFFFFu)); }
__device__ __forceinline__ unsigned dpp_ror(unsigned v, int n) {
    switch (n) { case 1: return (unsigned)__builtin_amdgcn_update_dpp(0, (int)v, 0x121, 0xF, 0xF, false);
                 case 2: return (unsigned)__builtin_amdgcn_update_dpp(0, (int)v, 0x122, 0xF, 0xF, false);
                 case 4: return (unsigned)__builtin_amdgcn_update_dpp(0, (int)v, 0x124, 0xF, 0xF, false);
                 default: return (unsigned)__builtin_amdgcn_update_dpp(0, (int)v, 0x128, 0xF, 0xF, false); }
}
__device__ __forceinline__ unsigned rowmax_u(unsigned m) { m = max(m, dpp_ror(m, 1)); m = max(m, dpp_ror(m, 2)); m = max(m, dpp_ror(m, 4)); m = max(m, dpp_ror(m, 8)); return m; }
__device__ __forceinline__ float rowsum_f(float m) {
    m += __uint_as_float(dpp_ror(__float_as_uint(m), 1)); m += __uint_as_float(dpp_ror(__float_as_uint(m), 2));
    m += __uint_as_float(dpp_ror(__float_as_uint(m), 4)); m += __uint_as_float(dpp_ror(__float_as_uint(m), 8)); return m; }
template <int NK>
__device__ __forceinline__ void extract16x4(unsigned (&k)[4][NK], unsigned (&mine)[4], int fr) {
#pragma unroll
    for (int r = 0; r < 4; ++r) {
        mine[r] = 0u;
#define CE_(i, j) { const unsigned hi_ = max(k[r][i], k[r][j]), lo_ = min(k[r][i], k[r][j]); k[r][i] = hi_; k[r][j] = lo_; }
        if (NK == 8) { CE_(0,1) CE_(2,3) CE_(4,5) CE_(6,7) CE_(0,2) CE_(1,3) CE_(4,6) CE_(5,7) CE_(1,2) CE_(5,6) CE_(0,4) CE_(1,5) CE_(2,6) CE_(3,7) CE_(2,4) CE_(3,5) CE_(1,2) CE_(3,4) CE_(5,6) }
        else { CE_(0,1) CE_(2,3) CE_(0,2) CE_(1,3) CE_(1,2) }
#undef CE_
    }
#pragma unroll 1
    for (int it = 0; it < 16; ++it) {
        unsigned m[4];
#pragma unroll
        for (int r = 0; r < 4; ++r) m[r] = k[r][0];
#pragma unroll
        for (int r = 0; r < 4; ++r) m[r] = max(m[r], dpp_ror(m[r], 1));
#pragma unroll
        for (int r = 0; r < 4; ++r) m[r] = max(m[r], dpp_ror(m[r], 2));
#pragma unroll
        for (int r = 0; r < 4; ++r) m[r] = max(m[r], dpp_ror(m[r], 4));
#pragma unroll
        for (int r = 0; r < 4; ++r) m[r] = max(m[r], dpp_ror(m[r], 8));
#pragma unroll
        for (int r = 0; r < 4; ++r) {
            const bool win = (k[r][0] == m[r]);
#pragma unroll
            for (int q = 0; q + 1 < NK; ++q) k[r][q] = win ? k[r][q + 1] : k[r][q];
            k[r][NK - 1] = win ? 0u : k[r][NK - 1];
            mine[r] = (fr == it) ? m[r] : mine[r]; }
    }
}
static __device__ const unsigned char CAND_TAB[64] = {0, 1, 2, 3, 4, 5, 6, 7, 8, 9, 10, 11, 12, 13, 14, 15, 16, 17, 18, 19, 20, 21, 22, 23, 32, 33, 34, 35, 36, 48, 49, 50, 51, 64, 65, 66, 80, 81, 96, 97, 112, 113, 128, 144, 160, 176, 192, 208, 224, 240, 255, 255, 255, 255, 255, 255, 255, 255, 255, 255, 255, 255, 255, 255};
__device__ __forceinline__ void topk_tile_lds(const bf16x8 (&qa)[2][4], const LAS bf16_t* SKL, LAS unsigned short* IDXW, LAS unsigned short* GWW, int t0, int h, int lane, const int (&cflat)[4]) {
    const int fr = lane & 15, fq = lane >> 4, rowb = lane & 48;
    const LAS bf16_t* skb = SKL + fr * 136 + 8 * fq;
    unsigned m1a[4], m2a[4];
#pragma unroll
    for (int p = 0; p < 2; ++p) {
        f32x4 sc[8];
#pragma unroll
        for (int nb = 0; nb < 8; ++nb) { f32x4 acc = {0.f, 0.f, 0.f, 0.f};
#pragma unroll
            for (int ks = 0; ks < 4; ++ks) { const bf16x8 bb = *(const LAS bf16x8*)(skb + (p * 128 + 16 * nb) * 136 + 32 * ks); acc = __builtin_amdgcn_mfma_f32_16x16x32_bf16(qa[p][ks], bb, acc, 0, 0, 0); }
            sc[nb] = acc; __builtin_amdgcn_sched_barrier(0); }
        unsigned k1[4][8];
#pragma unroll
        for (int r = 0; r < 4; ++r)
#pragma unroll
            for (int nb = 0; nb < 8; ++nb) k1[r][nb] = (ordkey(sc[nb][r]) & ~127u) | (127u - (unsigned)(16 * nb + fr));
        if (p == 0) extract16x4<8>(k1, m1a, fr); else extract16x4<8>(k1, m2a, fr);
    }
    float s1[4], s2[4]; int i1[4], i2[4]; unsigned ck[4][4];
#pragma unroll
    for (int r = 0; r < 4; ++r) { s1[r] = keyval(m1a[r] & ~127u); s2[r] = keyval(m2a[r] & ~127u); i1[r] = 127 - (int)(m1a[r] & 127u); i2[r] = 127 - (int)(m2a[r] & 127u); }
#pragma unroll
    for (int r = 0; r < 4; ++r)
#pragma unroll
        for (int q = 0; q < 4; ++q) { const int fl = cflat[q]; const float a1 = __shfl(s1[r], rowb + ((fl >> 4) & 15)), a2 = __shfl(s2[r], rowb + (fl & 15));
            ck[r][q] = (fl != 255) ? ((ordkey(a1 + a2) & ~255u) | (255u - (unsigned)fl)) : 0u; }
    unsigned mk[4];
    extract16x4<4>(ck, mk, fr);
#pragma unroll
    for (int r = 0; r < 4; ++r) {
        const int flat = 255 - (int)(mk[r] & 255u), ci = flat >> 4, cj = flat & 15;
        const int e1 = __shfl(i1[r], rowb + ci), e2 = __shfl(i2[r], rowb + cj);
        const float sv = keyval(mk[r] & ~255u);
        const float mx = keyval(rowmax_u(mk[r]) & ~255u);
        const float ex = __expf(sv - mx);
        const float gsm = ex / rowsum_f(ex);
        const int o = (4 * fq + r) * 128 + h * 16 + fr;
        IDXW[o] = (unsigned short)(e1 * 128 + e2); GWW[o] = __builtin_bit_cast(unsigned short, (_Float16)gsm);
    }
}


constexpr size_t BANDB = (size_t)16384 * 128;
template <bool SIGNED>
__device__ __forceinline__ void quant_rows(const float* tab, unsigned char* q8, float* scale, int gw, int NGW, int lane) {
#pragma unroll 2
    for (int r = gw; r < 16384; r += NGW) {
        const f32x4* src = (const f32x4*)(tab + (size_t)r * 1024 + 16 * lane);
        f32x4 v[4]; float mx = 0.f;
#pragma unroll
        for (int j = 0; j < 4; ++j) { v[j] = src[j]; mx = fmaxf(mx, fmaxf(fmaxf(fabsf(v[j].x), fabsf(v[j].y)), fmaxf(fabsf(v[j].z), fabsf(v[j].w)))); }
#pragma unroll
        for (int o = 1; o < 64; o <<= 1) mx = fmaxf(mx, __shfl_xor(mx, o));
        mx = fmaxf(mx, 1e-30f);
        const float inv = 127.0f / mx;
        u32x4 w;
#pragma unroll
        for (int j = 0; j < 4; ++j) {
            const int a = (int)rintf(v[j].x * inv), b = (int)rintf(v[j].y * inv), c = (int)rintf(v[j].z * inv), d = (int)rintf(v[j].w * inv);
            const int off = SIGNED ? 0 : 128;
            w[j] = (unsigned)((a + off) & 255) | ((unsigned)((b + off) & 255) << 8) | ((unsigned)((c + off) & 255) << 16) | ((unsigned)((d + off) & 255) << 24);
        }
        *(u32x4*)(q8 + (size_t)(lane >> 3) * BANDB + (size_t)r * 128 + 16 * (lane & 7)) = w;
        if (lane == 0) scale[r] = mx * (1.0f / 127.0f);
    }
}

__device__ __forceinline__ float gelu_tanh(float x) { const float y = 0.7978845608028654f * (x + 0.044715f * x * x * x); const float th = 1.0f - 2.0f * __builtin_amdgcn_rcpf(1.0f + __expf(2.0f * y)); return 0.5f * x * (1.0f + th); }
#define DPPI(v, ctrl) __builtin_amdgcn_update_dpp(0, (v), (ctrl), 0xF, 0xF, true)
typedef int i32x4 __attribute__((ext_vector_type(4)));
typedef int i32x2 __attribute__((ext_vector_type(2)));
__device__ __forceinline__ void p15_band(const Params& P, const bf16_t* Q0, const bf16_t* Q1, const bf16_t* SK, const unsigned char* XQ, const float* XS, const unsigned char* UQ, const float* US,
                                         const unsigned char* VQ, const float* VS, const bf16_t* HB, float* HO, LAS unsigned char* lds, int bid, int G, int lane, int wave) {
    const float* gfin = P.in[24];
    int cflat[4];
#pragma unroll
    for (int q = 0; q < 4; ++q) cflat[q] = CAND_TAB[q * 16 + (lane & 15)];
    const int seg = lane >> 3, dc = lane & 7;
    const unsigned dc16 = 16u * (unsigned)dc;
    LAS unsigned short* IDXW = (LAS unsigned short*)(lds) + wave * 2048;
    LAS unsigned short* GWW = (LAS unsigned short*)(lds + 32768) + wave * 2048;
    LAS int* DOTW = (LAS int*)(lds + 65536 + wave * 8192);
    LAS signed char* COEFW = (LAS signed char*)DOTW;
    LAS int* VSCR = DOTW + 512;
    LAS float* CSW = (LAS float*)(lds + 131072 + wave * 64);
#define PB_IDX(tk, I0, I1) do { const LAS u32x4* ip_ = (const LAS u32x4*)(IDXW + (tk) * 128 + seg * 16); I0 = ip_[0]; I1 = ip_[1]; } while (0)
#define PB_E(I0, I1, j) ((((j) < 8 ? I0 : I1)[((j) >> 1) & 3] >> (((j) & 1) * 16)) & 0xffffu)
#define PB_ROWS(tabb, I0, I1, R) do { _Pragma("unroll") for (int j = 0; j < 16; ++j) { const unsigned e_ = PB_E(I0, I1, j); R[j] = *(const u32x4*)((tabb) + (e_ * 128u + dc16)); } } while (0)
#define PB_UCOMP(R, X, tk, first) do { int part[16]; \
        _Pragma("unroll") for (int j = 0; j < 16; ++j) { int p = __builtin_amdgcn_sdot4((int)X.x, (int)R[j].x, 0, false); p = __builtin_amdgcn_sdot4((int)X.y, (int)R[j].y, p, false); \
            p = __builtin_amdgcn_sdot4((int)X.z, (int)R[j].z, p, false); p = __builtin_amdgcn_sdot4((int)X.w, (int)R[j].w, p, false); part[j] = p; } \
        _Pragma("unroll") for (int j = 0; j < 16; ++j) part[j] += DPPI(part[j], 0xB1); \
        _Pragma("unroll") for (int j = 0; j < 16; ++j) part[j] += DPPI(part[j], 0x4E); \
        _Pragma("unroll") for (int j = 0; j < 16; ++j) part[j] += DPPI(part[j], 0x141); \
        int v0 = part[0], v1 = part[8]; \
        _Pragma("unroll") for (int k = 1; k < 8; ++k) { v0 = (dc == k) ? part[k] : v0; v1 = (dc == k) ? part[k + 8] : v1; } \
        LAS int* dp_ = DOTW + (tk) * 128 + seg * 16 + dc; \
        if (first) { dp_[0] = v0; dp_[8] = v1; } else { (void)__hip_atomic_fetch_add(dp_, v0, __ATOMIC_RELAXED, __HIP_MEMORY_SCOPE_WORKGROUP); (void)__hip_atomic_fetch_add(dp_ + 8, v1, __ATOMIC_RELAXED, __HIP_MEMORY_SCOPE_WORKGROUP); } } while (0)
#define PB_VCOMP(R, C, HW, tk, OX, OY) do { int acc[16]; \
        _Pragma("unroll") for (int e = 0; e < 16; ++e) acc[e] = 0; \
        _Pragma("unroll") for (int g4 = 0; g4 < 4; ++g4) { const int cg_ = (int)C[g4]; \
            _Pragma("unroll") for (int r = 0; r < 4; ++r) { \
                const unsigned a0 = R[4 * g4][r], a1 = R[4 * g4 + 1][r], a2 = R[4 * g4 + 2][r], a3 = R[4 * g4 + 3][r]; \
                const unsigned p01a = __builtin_amdgcn_perm(a1, a0, 0x05010400u), p01b = __builtin_amdgcn_perm(a1, a0, 0x07030602u); \
                const unsigned p23a = __builtin_amdgcn_perm(a3, a2, 0x05010400u), p23b = __builtin_amdgcn_perm(a3, a2, 0x07030602u); \
                acc[4 * r + 0] = __builtin_amdgcn_sdot4((int)__builtin_amdgcn_perm(p23a, p01a, 0x05040100u), cg_, acc[4 * r + 0], false); \
                acc[4 * r + 1] = __builtin_amdgcn_sdot4((int)__builtin_amdgcn_perm(p23a, p01a, 0x07060302u), cg_, acc[4 * r + 1], false); \
                acc[4 * r + 2] = __builtin_amdgcn_sdot4((int)__builtin_amdgcn_perm(p23b, p01b, 0x05040100u), cg_, acc[4 * r + 2], false); \
                acc[4 * r + 3] = __builtin_amdgcn_sdot4((int)__builtin_amdgcn_perm(p23b, p01b, 0x07060302u), cg_, acc[4 * r + 3], false); } } \
        LAS i32x4* sw_ = (LAS i32x4*)(VSCR + seg * 128 + dc * 16); \
        _Pragma("unroll") for (int r = 0; r < 4; ++r) { i32x4 w_; w_.x = acc[4 * r]; w_.y = acc[4 * r + 1]; w_.z = acc[4 * r + 2]; w_.w = acc[4 * r + 3]; sw_[r] = w_; } \
        int s0 = 0, s1 = 0; \
        _Pragma("unroll") for (int sg = 0; sg < 8; ++sg) { const i32x2 v_ = *(const LAS i32x2*)(VSCR + sg * 128 + 2 * lane); s0 += v_.x; s1 += v_.y; } \
        const float cs_ = CSW[tk]; \
        OX = (float)s0 * cs_ + bflo(HW); OY = (float)s1 * cs_ + bfhi(HW); } while (0)
    for (int tb = bid; tb < 256; tb += G) {
        const int t0 = tb * 128 + wave * 16;
        {
            LAS bf16_t* SKL = (LAS bf16_t*)(lds + 65536);
            bf16x8 qa[2][4];
#define PB_QLOAD(h_) do { const bf16_t* qb_ = ((h_) < 4 ? Q0 : Q1) + (size_t)(t0 + (lane & 15)) * 1024 + ((h_) & 3) * 256 + 8 * (lane >> 4); \
                _Pragma("unroll") for (int p = 0; p < 2; ++p) _Pragma("unroll") for (int ks = 0; ks < 4; ++ks) qa[p][ks] = *(const bf16x8*)(qb_ + p * 128 + 32 * ks); } while (0)
            const int ptid = wave * 64 + lane;
            const unsigned sktoff = (unsigned)(((ptid >> 4) * 128 + (ptid & 15) * 8) * 2);
            u32x4 skr[8];
#define PB_SKLOAD(h_) do { const char* skh_ = (const char*)SK + (size_t)(h_) * 65536; _Pragma("unroll") for (int i = 0; i < 8; ++i) skr[i] = *(const u32x4*)(skh_ + i * 8192 + sktoff); } while (0)
            PB_SKLOAD(0); PB_QLOAD(0);
#pragma unroll 1
            for (int h = 0; h < 8; ++h) {
                __syncthreads();
#pragma unroll
                for (int i = 0; i < 8; ++i) { const int p = ptid + 512 * i; *(LAS u32x4*)(SKL + (p >> 4) * 136 + (p & 15) * 8) = skr[i]; }
                __syncthreads();
                topk_tile_lds(qa, SKL, IDXW, GWW, t0, h, lane, cflat);
                { const int hn = h < 7 ? h + 1 : 7; PB_SKLOAD(hn); PB_QLOAD(hn); }
            }
            __syncthreads();
        }
        {
            u32x4 rA[16], rB[16], xA, xB, iA0, iA1, iB0, iB1;
            const unsigned char* xb = XQ + (size_t)t0 * 1024 + dc16;
            PB_IDX(0, iA0, iA1); PB_ROWS(UQ, iA0, iA1, rA); xA = *(const u32x4*)(xb); PB_IDX(1, iB0, iB1);
#pragma unroll 1
            for (int it = 0; it < 128; it += 2) {
                const int band = it >> 4, tk = it & 15;
                const unsigned char* ub = UQ + (size_t)band * BANDB;
                const int it2 = it + 2 < 128 ? it + 2 : 127, band2 = it2 >> 4, tk2 = it2 & 15; const unsigned char* ub2 = UQ + (size_t)band2 * BANDB;
                const int it3 = it + 3 < 128 ? it + 3 : 127, tk3 = it3 & 15;
                PB_ROWS(ub, iB0, iB1, rB); xB = *(const u32x4*)(xb + (tk + 1) * 1024 + band * 128); PB_IDX(tk2, iA0, iA1);
                __builtin_amdgcn_sched_barrier(0); PB_UCOMP(rA, xA, tk, it < 16); __builtin_amdgcn_sched_barrier(0);
                PB_ROWS(ub2, iA0, iA1, rA); xA = *(const u32x4*)(xb + tk2 * 1024 + band2 * 128); PB_IDX(tk3, iB0, iB1);
                __builtin_amdgcn_sched_barrier(0); PB_UCOMP(rB, xB, tk + 1, it < 16); __builtin_amdgcn_sched_barrier(0);
            }
        }
#pragma unroll 2
        for (int tk = 0; tk < 16; ++tk) {
            const int e0 = IDXW[tk * 128 + lane], e1 = IDXW[tk * 128 + 64 + lane];
            const float g0 = (float)__builtin_bit_cast(_Float16, GWW[tk * 128 + lane]), g1 = (float)__builtin_bit_cast(_Float16, GWW[tk * 128 + 64 + lane]);
            const int d0 = DOTW[tk * 128 + lane], d1 = DOTW[tk * 128 + 64 + lane];
            const float xs = XS[t0 + tk];
            const float c0 = gelu_tanh((float)d0 * xs * US[e0]) * g0 * VS[e0], c1 = gelu_tanh((float)d1 * xs * US[e1]) * g1 * VS[e1];
            float mx = fmaxf(fabsf(c0), fabsf(c1));
#pragma unroll
            for (int o = 1; o < 64; o <<= 1) mx = fmaxf(mx, __shfl_xor(mx, o));
            mx = fmaxf(mx, 1e-30f);
            const float inv = 127.0f / mx;
            COEFW[tk * 128 + lane] = (signed char)(int)rintf(c0 * inv); COEFW[tk * 128 + 64 + lane] = (signed char)(int)rintf(c1 * inv);
            if (lane == 0) CSW[tk] = mx * (1.0f / 127.0f);
        }
        {
            u32x4 rA[16], rB[16], cA, cB, iA0, iA1, iB0, iB1; unsigned hA, hB;
            bf16_t* hbw = (bf16_t*)HB + (size_t)t0 * 1024 + 2 * lane;
            const bf16_t* hb = hbw;
            PB_IDX(0, iA0, iA1); PB_ROWS(VQ, iA0, iA1, rA); cA = *(const LAS u32x4*)(COEFW + seg * 16); hA = *(const unsigned*)(hb); PB_IDX(1, iB0, iB1);
#pragma unroll 1
            for (int it = 0; it < 112; it += 2) {
                const int band = it >> 4, tk = it & 15;
                const unsigned char* vb = VQ + (size_t)band * BANDB;
                const int it2 = it + 2, band2 = it2 >> 4, tk2 = it2 & 15, tk3 = (it + 3) & 15; const unsigned char* vb2 = VQ + (size_t)band2 * BANDB;
                PB_ROWS(vb, iB0, iB1, rB); cB = *(const LAS u32x4*)(COEFW + (tk + 1) * 128 + seg * 16); hB = *(const unsigned*)(hb + (tk + 1) * 1024 + band * 128); PB_IDX(tk2, iA0, iA1);
                __builtin_amdgcn_sched_barrier(0); { float ox, oy; PB_VCOMP(rA, cA, hA, tk, ox, oy); *(unsigned*)(hbw + tk * 1024 + band * 128) = pk2(ox, oy); } __builtin_amdgcn_sched_barrier(0);
                PB_ROWS(vb2, iA0, iA1, rA); cA = *(const LAS u32x4*)(COEFW + tk2 * 128 + seg * 16); hA = *(const unsigned*)(hb + tk2 * 1024 + band2 * 128); PB_IDX(tk3, iB0, iB1);
                __builtin_amdgcn_sched_barrier(0); { float ox, oy; PB_VCOMP(rB, cB, hB, tk + 1, ox, oy); *(unsigned*)(hbw + (tk + 1) * 1024 + band * 128) = pk2(ox, oy); } __builtin_amdgcn_sched_barrier(0);
            }
            unsigned pA[7], pB[7];
#define PB_PREV(tk, PV) do { _Pragma("unroll") for (int b_ = 0; b_ < 7; ++b_) PV[b_] = __hip_atomic_load((const unsigned*)(hb + (tk) * 1024 + b_ * 128), __ATOMIC_RELAXED, __HIP_MEMORY_SCOPE_AGENT); } while (0)
#define PB_FINAL(PV, OX, OY, tk) do { float vals[16]; \
                _Pragma("unroll") for (int b_ = 0; b_ < 7; ++b_) { vals[2 * b_] = bflo(PV[b_]); vals[2 * b_ + 1] = bfhi(PV[b_]); } vals[14] = OX; vals[15] = OY; \
                float ss_ = 0.f; _Pragma("unroll") for (int e = 0; e < 16; ++e) ss_ += vals[e] * vals[e]; \
                const float rs_ = rsqrtf(wave_sum(ss_) * (1.0f / 1024.0f) + 1e-6f); \
                float* hr_ = HO + (size_t)(t0 + (tk)) * 1024 + 2 * lane; \
                _Pragma("unroll") for (int b_ = 0; b_ < 8; ++b_) { const cf2 g_ = *(const cf2*)(gfin + b_ * 128 + 2 * lane); cf2 o_; o_.x = vals[2 * b_] * rs_ * g_.x; o_.y = vals[2 * b_ + 1] * rs_ * g_.y; __builtin_nontemporal_store(o_, (cf2*)(hr_ + b_ * 128)); } } while (0)
            PB_PREV(0, pA);
            const unsigned char* vb7 = VQ + (size_t)7 * BANDB;
#pragma unroll 1
            for (int tk = 0; tk < 16; tk += 2) {
                const int tk2 = tk + 2 < 16 ? tk + 2 : 15, tk3 = tk + 3 < 16 ? tk + 3 : 15;
                PB_ROWS(vb7, iB0, iB1, rB); cB = *(const LAS u32x4*)(COEFW + (tk + 1) * 128 + seg * 16); hB = *(const unsigned*)(hb + (tk + 1) * 1024 + 7 * 128); PB_PREV(tk + 1, pB); PB_IDX(tk2, iA0, iA1);
                __builtin_amdgcn_sched_barrier(0); { float ox, oy; PB_VCOMP(rA, cA, hA, tk, ox, oy); PB_FINAL(pA, ox, oy, tk); } __builtin_amdgcn_sched_barrier(0);
                PB_ROWS(vb7, iA0, iA1, rA); cA = *(const LAS u32x4*)(COEFW + tk2 * 128 + seg * 16); hA = *(const unsigned*)(hb + tk2 * 1024 + 7 * 128); PB_PREV(tk2, pA); PB_IDX(tk3, iB0, iB1);
                __builtin_amdgcn_sched_barrier(0); { float ox, oy; PB_VCOMP(rB, cB, hB, tk + 1, ox, oy); PB_FINAL(pB, ox, oy, tk + 1); } __builtin_amdgcn_sched_barrier(0);
            }
#undef PB_PREV
#undef PB_FINAL
        }
    }
#undef PB_IDX
#undef PB_E
#undef PB_ROWS
#undef PB_UCOMP
#undef PB_VCOMP
}

#define XB_TMO      128
#define XB_XCNT(j)  (256  + 64 * (j))
#define XB_XSUB(j)  (1280 + 64 * (j))
#define XB_XGEN(j)  (2304 + 64 * (j))
#define XB_TOP      3328
#define XB_TOPGEN   3392
#define XCD_BAR_WORDS 3456
#define XB_SPIN_CAP (1u << 18)

__device__ __forceinline__ unsigned xb_ld(unsigned* p)              { return __hip_atomic_load(p, __ATOMIC_RELAXED, __HIP_MEMORY_SCOPE_AGENT); }
__device__ __forceinline__ unsigned xb_add(unsigned* p, unsigned v) { return __hip_atomic_fetch_add(p, v, __ATOMIC_RELAXED, __HIP_MEMORY_SCOPE_AGENT); }
__device__ __forceinline__ unsigned xb_xcc_id() { return (unsigned)__builtin_amdgcn_s_getreg((3 << 11) | 20) & 0xFu; }
#define XB_SPIN(cond, bar) do { unsigned _sp = 0; while (cond) { __builtin_amdgcn_s_sleep(1); \
    if ((++_sp & 255u) == 0u) { if (xb_ld(&(bar)[XB_TMO])) break; if (_sp > XB_SPIN_CAP) { atomicAdd(&(bar)[XB_TMO], 1u); break; } } } } while (0)

struct XcdBarrier {
    unsigned* bar; unsigned x;
    volatile LAS unsigned* st;
};

__device__ __forceinline__ XcdBarrier xcd_barrier_post(unsigned* bar, volatile LAS unsigned* st) {
    XcdBarrier b; b.bar = bar; b.x = xb_xcc_id(); b.st = st;
    if (threadIdx.x == 0) (void)xb_add(&bar[XB_XCNT(b.x)], 1u);
    return b;
}
__device__ __forceinline__ void xcd_barrier_complete(unsigned* bar, unsigned x, unsigned& nloc, unsigned& nx) {
    const unsigned G = gridDim.x * gridDim.y * gridDim.z;
    unsigned sum, cnt, mine, sp = 0u;
    for (;;) {
        sum = 0u; cnt = 0u; mine = 0u;
#pragma unroll
        for (unsigned j = 0; j < 16; ++j) { const unsigned c = xb_ld(&bar[XB_XCNT(j)]); sum += c; cnt += (c > 0u) ? 1u : 0u; mine = (j == x) ? c : mine; }
        if (sum == G) break;
        __builtin_amdgcn_s_sleep(1);
        if ((++sp & 255u) == 0u) { if (xb_ld(&bar[XB_TMO])) break; if (sp > XB_SPIN_CAP) { atomicAdd(&bar[XB_TMO], 1u); break; } }
    }
    nloc = mine > 0u ? mine : 1u; nx = cnt > 0u ? cnt : 1u;
}

__device__ __forceinline__ void xcd_barrier(const XcdBarrier& b) {
    asm volatile("s_waitcnt vmcnt(0)" ::: "memory");
    __syncthreads();
    if (threadIdx.x == 0) {
        unsigned* bar = b.bar;
        __builtin_amdgcn_s_waitcnt(0);
        unsigned nloc = b.st[0], nx = b.st[1];
        if (nloc == 0u) { xcd_barrier_complete(bar, b.x, nloc, nx); b.st[0] = nloc; b.st[1] = nx; }
        const unsigned old = xb_add(&bar[XB_XSUB(b.x)], 1u);
        const unsigned gen = old / nloc;
        if (old + 1u == (gen + 1u) * nloc) {
            __builtin_amdgcn_fence(__ATOMIC_RELEASE, "agent");
            asm volatile("s_waitcnt vmcnt(0)" ::: "memory");
            const unsigned og = xb_add(&bar[XB_TOP], 1u);
            const unsigned tg = og / nx;
            if (og + 1u == (tg + 1u) * nx) xb_add(&bar[XB_TOPGEN], 1u);
            else XB_SPIN(xb_ld(&bar[XB_TOPGEN]) == tg, bar);
            __builtin_amdgcn_fence(__ATOMIC_ACQUIRE, "agent");
            asm volatile("s_waitcnt vmcnt(0)" ::: "memory");
        } else {
            XB_SPIN(xb_ld(&bar[XB_TOPGEN]) == gen, bar);
            __builtin_amdgcn_fence(__ATOMIC_ACQUIRE, "agent");
            asm volatile("s_waitcnt vmcnt(0)" ::: "memory");
        }
    }
    __syncthreads();
}


__device__ __forceinline__ void split_arrive(const XcdBarrier& b, unsigned* w, unsigned inst) {
    asm volatile("s_waitcnt vmcnt(0)" ::: "memory");
    __syncthreads();
    if (threadIdx.x == 0) {
        unsigned nloc = b.st[0], nx = b.st[1];
        if (nloc == 0u) { xcd_barrier_complete(b.bar, b.x, nloc, nx); b.st[0] = nloc; b.st[1] = nx; }
        const unsigned old = xb_add(&b.bar[XB_XGEN(b.x)], 1u);
        if (old + 1u == (inst + 1u) * nloc) { __builtin_amdgcn_fence(__ATOMIC_RELEASE, "agent"); asm volatile("s_waitcnt vmcnt(0)" ::: "memory"); (void)xb_add(w, nloc); }
    }
}
__device__ __forceinline__ void split_wait(unsigned* w, unsigned need) {
    if (threadIdx.x == 0) { unsigned sp = 0u; while (xb_ld(w) < need) { __builtin_amdgcn_s_sleep(1); if (++sp > (1u << 22)) break; }
        __builtin_amdgcn_fence(__ATOMIC_ACQUIRE, "agent"); asm volatile("s_waitcnt vmcnt(0)" ::: "memory"); }
    __syncthreads();
}
constexpr int NPHASES = 16;
__global__ void __launch_bounds__(NTHREADS, 2) fwd_megakernel(Params P) {
    extern __shared__ __attribute__((aligned(16))) unsigned char lds_raw[];
    LAS unsigned char* lds = (LAS unsigned char*)lds_raw;
    cg::grid_group grid = cg::this_grid();
    const int G = gridDim.x, NGW = G * 8;
    const int lo = P.ph_lo, hi = P.ph_hi;
    volatile LAS unsigned* xbst = (volatile LAS unsigned*)(lds + LDS_BYTES - 64);
    if (threadIdx.x < 4) xbst[threadIdx.x] = 0u;
    __syncthreads();
    XcdBarrier xbar = xcd_barrier_post((unsigned*)(P.ws + (size_t)P.bar_region * (XCD_BAR_WORDS * 4)), xbst);
    if (P.ph_hi > 1000) grid.sync();
#define WSP (P.ws)
#define OUTP (P.out)
#define R0 ((bf16_t*)(WSP + WS_R0))
#define R1 ((bf16_t*)(WSP + WS_R0 + WS_RS))
#define R2 ((bf16_t*)(WSP + WS_R0 + 2 * WS_RS))
#define R3 ((bf16_t*)(WSP + WS_R0 + 3 * WS_RS))
#define R4 ((bf16_t*)(WSP + WS_R0 + 4 * WS_RS))
#define R5 ((bf16_t*)(WSP + WS_R0 + 5 * WS_RS))
#define O0 ((bf16_t*)OUTP)
#define O1 ((bf16_t*)((unsigned char*)OUTP + WS_RS))
#define XN ((bf16_t*)(WSP + WS_XN))
#define WIN ((bf16_t*)(WSP + WS_WIN))
#define UQ8 ((unsigned char*)(WSP + 48 * MiB))
#define VQ8 ((unsigned char*)(WSP + WS_R0 + 2 * WS_RS + 16 * MiB))
#define USC ((float*)(WSP + 47 * MiB + 256 * 1024))
#define VSC ((float*)(WSP + WS_R0 + 2 * WS_RS + 33 * MiB))
#define XQ8 ((unsigned char*)(WSP + WS_R0 + 4 * WS_RS))
#define XSC ((float*)(WSP + WS_R0 + 4 * WS_RS + 32 * MiB))
#define RSTD2 ((float*)(WSP + WS_R0 + 4 * WS_RS + 33 * MiB))
#define RSTD1 ((const float*)(WSP + WS_RSTD1))
#define PHASE_BEGIN(k) if (lo <= (k) && (k) < hi) { \
        const int tid = threadIdx.x, lane = tid & 63, wave = __builtin_amdgcn_readfirstlane(tid >> 6), bid = blockIdx.x, gw = bid * 8 + wave; (void)lane; (void)gw;
#define PHASE_END(k) if ((k) + 1 < hi) xcd_barrier(xbar); }
#define SPLITW(k) ((unsigned*)(P.ws + (size_t)P.bar_region * (XCD_BAR_WORDS * 4)) + 64 * (k))
#define SPLITWA ((unsigned*)(P.ws + (size_t)P.bar_region * (XCD_BAR_WORDS * 4)) + 32)
#define SPLITWB ((unsigned*)(P.ws + (size_t)P.bar_region * (XCD_BAR_WORDS * 4)) + 96)
#define SPLITWC ((unsigned*)(P.ws + (size_t)P.bar_region * (XCD_BAR_WORDS * 4)) + 160)
#define EPI_INIT pg8::EpiGen E; E.o0 = E.o1 = E.o2 = E.o3 = E.o4 = nullptr; E.actbits = 0; E.mulmask = 0; E.mul = nullptr; E.add = nullptr; E.resid = nullptr; E.outf = nullptr; E.rowscale = nullptr; E.waitword = nullptr; E.need = 0u; E.wflag = nullptr;
#define RUN_GEMM(Aptr, Bptr, Ncols) do { __syncthreads(); pg8::Gemm g{(Aptr), (Bptr), T_, (Ncols), 1024}; pg8::StaticOrder S; S.init(T_, (Ncols), G, bid); \
        pg8::gemm_phase<pg8::EpiGen, pg8::StaticOrder, true, true>(lds, g, S, E); } while (0)

    PHASE_BEGIN(0) p0_prep(P, WSP, lds, gw, NGW, lane, wave, 0); split_arrive(xbar, SPLITWA, 0u); p0_prep(P, WSP, lds, gw, NGW, lane, wave, 1); split_wait(SPLITWA, (unsigned)G);
        p1_filt(P, (const float*)(WSP + WS_HID), (float*)R5, tid, bid);
        { EPI_INIT E.o0 = R0; E.o1 = R1; E.o2 = R2; E.rowscale = RSTD1; RUN_GEMM(XN, WIN + (size_t)4096 * 1024, 3072); } PHASE_END(0)
    PHASE_BEGIN(2) p2_conv(P, R0, R1, R2, R3, R4, lds, gw, NGW, lane, wave); PHASE_END(2)
    PHASE_BEGIN(3) p3_fft((const float*)R5, R3, (cf2*)R0, lds, tid, bid); PHASE_END(3)
    PHASE_BEGIN(5) p4_yb(R3, R4, lds, gw, NGW, lane, wave);
        EPI_INIT E.o0 = R0; E.o1 = R1; E.o2 = R2; E.o3 = R5; E.actbits = 1; E.rowscale = RSTD1; RUN_GEMM(XN, WIN, 4096); PHASE_END(5)
    PHASE_BEGIN(6) p6a_prep(P, R0, R1, R2, R3, (float*)(WSP + WS_FAC), lds, tid, bid); PHASE_END(6)
    PHASE_BEGIN(7) p6b_scan(R0, R1, R2, R3, R5, (const float*)(WSP + WS_FAC), O0, O1, lds, tid, lane, wave, bid); PHASE_END(7)
    PHASE_BEGIN(8) p7_aa(P, O0, O1, R0, gw, NGW, lane); split_arrive(xbar, SPLITW(0), 1u);
        { EPI_INIT E.o0 = R0; E.o1 = R1; E.o2 = R2; E.actbits = 1 | (2 << 2) | (2 << 4); E.mul = R0; E.mulmask = 1; E.waitword = SPLITW(0); E.need = (unsigned)G; E.wflag = xbst + 2;
          E.rowscale = RSTD1; RUN_GEMM(XN, WIN + (size_t)7168 * 1024, 3072); } PHASE_END(8)
    PHASE_BEGIN(10) { EPI_INIT E.o0 = R3; E.mul = R1; E.mulmask = 1; RUN_GEMM(R0, (bf16_t*)(WSP + WS_WA), 1024); }
        { EPI_INIT E.o0 = R5; E.mul = R2; E.mulmask = 1; E.add = R3; RUN_GEMM(R4, (bf16_t*)(WSP + WS_WB), 1024); }
        split_arrive(xbar, SPLITWC, 2u); quant_rows<true>(P.in[22], UQ8, USC, gw, NGW, lane); split_wait(SPLITWC, (unsigned)G);
        { EPI_INIT E.add = XN; E.o0 = R3; RUN_GEMM(R5, (bf16_t*)(WSP + WS_WO), 1024); }
        split_arrive(xbar, SPLITWB, 3u);
        quant_rows<true>(P.in[23], VQ8, VSC, gw, NGW, lane);
        split_wait(SPLITWB, (unsigned)G);
        _Pragma("unroll 2") for (int m = gw; m < T_; m += NGW) rms_rowbf_q(R3 + (size_t)m * D_, P.in[19], XQ8 + (size_t)m * D_, XSC + m, RSTD2 + m, lane);
        split_arrive(xbar, SPLITW(1), 4u);
        { EPI_INIT E.o0 = R0; E.o1 = R1; E.rowscale = RSTD2; E.waitword = SPLITW(1); E.need = (unsigned)G; E.wflag = xbst + 3; RUN_GEMM(R3, (bf16_t*)(WSP + WS_WQ), 2048); } PHASE_END(12)
    PHASE_BEGIN(15) p15_band(P, R0, R1, (const bf16_t*)(WSP + WS_SK), XQ8, XSC, UQ8, USC, VQ8, VSC, R3, OUTP, lds, bid, G, lane, wave); PHASE_END(15)
}

extern "C" void kernel_launch(void* const* d_in, const int* in_sizes, int n_in, void* d_out, int out_size, void* d_ws, size_t ws_size, hipStream_t stream) {
    static int grid_blocks = 0;
    if (grid_blocks == 0) {
        int dev = 0, cus = 0, per_cu = 0;
        (void)hipGetDevice(&dev);
        (void)hipDeviceGetAttribute(&cus, hipDeviceAttributeMultiprocessorCount, dev);
        (void)hipFuncSetAttribute((const void*)fwd_megakernel, hipFuncAttributeMaxDynamicSharedMemorySize, LDS_BYTES);
        (void)hipOccupancyMaxActiveBlocksPerMultiprocessor(&per_cu, (const void*)fwd_megakernel, NTHREADS, LDS_BYTES);
        (void)hipGetLastError();
        if (n_in != 25 || out_size != T_ * D_ || ws_size < WS_END || per_cu < 1 || cus < 1) {
            fprintf(stderr, "kernel_launch: unexpected problem (n_in %d out %d ws %zu per_cu %d cus %d); nothing launched\n", n_in, out_size, ws_size, per_cu, cus); grid_blocks = -1; return; }
        grid_blocks = cus;
    }
    if (grid_blocks < 0) return;
    Params p{};
    for (int i = 0; i < 25; ++i) p.in[i] = (const float*)d_in[i];
    p.out = (float*)d_out; p.ws = (unsigned char*)d_ws;
#ifndef PROBE_SEQ
#define PROBE_SEQ {0, NPHASES}
#endif
    const int seq[] = PROBE_SEQ;
    (void)hipMemsetAsync(d_ws, 0, (sizeof(seq) / sizeof(int) / 2) * (size_t)(XCD_BAR_WORDS * 4), stream);
    for (unsigned i = 0; i + 1 < sizeof(seq) / sizeof(int); i += 2) {
        p.ph_lo = seq[i]; p.ph_hi = seq[i + 1]; p.bar_region = (int)(i / 2); p.pad = 0;
        void* args[] = {&p};
        hipError_t e = hipLaunchCooperativeKernel((void*)fwd_megakernel, dim3(grid_blocks), dim3(NTHREADS), args, LDS_BYTES, stream);
        if (e != hipSuccess) fprintf(stderr, "cooperative launch failed: %s (grid %d)\n", hipGetErrorString(e), grid_blocks);
    }
}
```
